# Optimizing an MI355X kernel written in HIP

```python
import jax, jax.numpy as jnp
from jax import lax
import numpy as np

D_MODEL = 1024
BATCH = 4
SEQ = 4096
DEPTH = 4

D_LRU = D_MODEL // 2
D_SC = D_MODEL - D_LRU
D_MIX = D_LRU + D_SC
LRU_HEADS = 8
LRU_HEAD_DIM = D_LRU // LRU_HEADS
SC_GROUPS = 8
LRU_CONV = 4
SC_CONV = 3
LRU_C = 8.0
D_IN = 2 * D_LRU + 3 * D_SC
D_FF = 2816
N_EXPERTS = 8
TOP_K = 2
D_FF_EXPERT = 1408
N_DENSE = (DEPTH + 1) // 2
N_MOE = DEPTH // 2
EPS = 1e-6

kernel_name = "hymba_rglru_shortconv_moe_adaln"


def rms_norm(x, g):
    xf = x.astype(jnp.float32)
    y = xf * lax.rsqrt(jnp.mean(xf * xf, axis=-1, keepdims=True) + EPS)
    return (y * g.astype(jnp.float32)).astype(x.dtype)


def group_rms_norm(y, g, n_groups):
    b, s, ch = y.shape
    yf = y.astype(jnp.float32).reshape(b, s, n_groups, ch // n_groups)
    yf = yf * lax.rsqrt(jnp.mean(yf * yf, axis=-1, keepdims=True) + EPS)
    return (yf.reshape(b, s, ch) * g.astype(jnp.float32)).astype(y.dtype)


def causal_depthwise_conv(x, w):
    k, ch = w.shape
    return lax.conv_general_dilated(
        x, w[:, None, :].astype(x.dtype), window_strides=(1,), padding=[(k - 1, 0)],
        dimension_numbers=("NWC", "WIO", "NWC"), feature_group_count=ch)


def adaln(c, w_mod, b_mod):
    m = jax.nn.silu(c) @ w_mod + b_mod
    shift, scale, gate = jnp.split(m, 3, axis=-1)
    return shift[:, None, :], scale[:, None, :], gate[:, None, :]


def rg_lru(x, w_a, b_a, w_i, b_i, lam):
    b, s, _ = x.shape
    xh = x.reshape(b, s, LRU_HEADS, LRU_HEAD_DIM)
    r = jax.nn.sigmoid(jnp.einsum("bshi,hij->bshj", xh, w_a) + b_a).reshape(b, s, D_LRU)
    i = jax.nn.sigmoid(jnp.einsum("bshi,hij->bshj", xh, w_i) + b_i).reshape(b, s, D_LRU)
    log_a = -LRU_C * r.astype(jnp.float32) * jax.nn.softplus(-lam.astype(jnp.float32))
    a = jnp.exp(log_a)
    u = jnp.sqrt(-jnp.expm1(2.0 * log_a)) * (i * x).astype(jnp.float32)

    def combine(left, right):
        a1, b1 = left
        a2, b2 = right
        return a1 * a2, a2 * b1 + b2

    _, h = lax.associative_scan(combine, (a, u), axis=1)
    return h.astype(x.dtype)


def hybrid_mixer(h, w_in, lru_conv_w, lru_conv_b, lru_wa, lru_ba, lru_wi, lru_bi, lru_lambda,
                 sc_conv_w, gn_lru, gn_sc, w_out):
    u = h @ w_in
    x_lru, g_lru, b_sc, c_sc, x_sc = jnp.split(
        u, [D_LRU, 2 * D_LRU, 2 * D_LRU + D_SC, 2 * D_LRU + 2 * D_SC], axis=-1)
    xc = causal_depthwise_conv(x_lru, lru_conv_w) + lru_conv_b
    y_lru = jax.nn.gelu(g_lru) * rg_lru(xc, lru_wa, lru_ba, lru_wi, lru_bi, lru_lambda)
    y_sc = b_sc * causal_depthwise_conv(c_sc * x_sc, sc_conv_w)
    y = jnp.concatenate([group_rms_norm(y_lru, gn_lru, LRU_HEADS),
                         group_rms_norm(y_sc, gn_sc, SC_GROUPS)], axis=-1)
    return y @ w_out


def swiglu(h, w1, w3, w2):
    return (jax.nn.silu(h @ w1) * (h @ w3)) @ w2


def moe_swiglu(h, w_router, b_router, w1, w3, w2):
    b, s, d = h.shape
    t = h.reshape(b * s, d)
    logits = t.astype(jnp.float32) @ w_router.astype(jnp.float32) + b_router.astype(jnp.float32)
    vals, idx = lax.top_k(logits, TOP_K)
    wts = jax.nn.softmax(vals, axis=-1)
    combine = jnp.sum(jax.nn.one_hot(idx, N_EXPERTS, dtype=jnp.float32) * wts[..., None],
                      axis=1).astype(h.dtype)
    out = jnp.zeros_like(t)
    for e in range(N_EXPERTS):
        out = out + combine[:, e:e + 1] * swiglu(t, w1[e], w3[e], w2[e])
    return out.reshape(b, s, d)


def setup_inputs(seed: int = 0) -> dict:
    key = jax.random.key(seed)
    ks = iter(jax.random.split(key, 40))
    f32 = jnp.float32

    def nrm(shape, scale):
        return jax.random.normal(next(ks), shape, f32) * scale

    def gain(shape):
        return 1.0 + nrm(shape, 0.02)

    x = nrm((BATCH, SEQ, D_MODEL), 1.0)
    c = nrm((BATCH, D_MODEL), 1.0)
    mix_norm = gain((DEPTH, D_MODEL))
    mix_mod_w = nrm((DEPTH, D_MODEL, 3 * D_MODEL), 0.5 * D_MODEL ** -0.5)
    mix_mod_b = nrm((DEPTH, 3 * D_MODEL), 0.02)
    w_in = nrm((DEPTH, D_MODEL, D_IN), D_MODEL ** -0.5)
    lru_conv_w = nrm((DEPTH, LRU_CONV, D_LRU), LRU_CONV ** -0.5)
    lru_conv_b = nrm((DEPTH, D_LRU), 0.02)
    lru_wa = nrm((DEPTH, LRU_HEADS, LRU_HEAD_DIM, LRU_HEAD_DIM), LRU_HEAD_DIM ** -0.5)
    lru_ba = nrm((DEPTH, LRU_HEADS, LRU_HEAD_DIM), 0.02)
    lru_wi = nrm((DEPTH, LRU_HEADS, LRU_HEAD_DIM, LRU_HEAD_DIM), LRU_HEAD_DIM ** -0.5)
    lru_bi = nrm((DEPTH, LRU_HEADS, LRU_HEAD_DIM), 0.02)
    a_c = jax.random.uniform(next(ks), (DEPTH, D_LRU), f32, 0.9, 0.999)
    a_base = a_c ** (1.0 / LRU_C)
    lru_lambda = jnp.log(a_base) - jnp.log1p(-a_base)
    sc_conv_w = nrm((DEPTH, SC_CONV, D_SC), SC_CONV ** -0.5)
    gn_lru = gain((DEPTH, D_LRU))
    gn_sc = gain((DEPTH, D_SC))
    w_out = nrm((DEPTH, D_MIX, D_MODEL), D_MIX ** -0.5)
    ffn_norm = gain((DEPTH, D_MODEL))
    ffn_mod_w = nrm((DEPTH, D_MODEL, 3 * D_MODEL), 0.5 * D_MODEL ** -0.5)
    ffn_mod_b = nrm((DEPTH, 3 * D_MODEL), 0.02)
    dense_w1 = nrm((N_DENSE, D_MODEL, D_FF), D_MODEL ** -0.5)
    dense_w3 = nrm((N_DENSE, D_MODEL, D_FF), D_MODEL ** -0.5)
    dense_w2 = nrm((N_DENSE, D_FF, D_MODEL), D_FF ** -0.5)
    router_w = nrm((N_MOE, D_MODEL, N_EXPERTS), D_MODEL ** -0.5)
    router_b = nrm((N_MOE, N_EXPERTS), 0.01)
    exp_w1 = nrm((N_MOE, N_EXPERTS, D_MODEL, D_FF_EXPERT), D_MODEL ** -0.5)
    exp_w3 = nrm((N_MOE, N_EXPERTS, D_MODEL, D_FF_EXPERT), D_MODEL ** -0.5)
    exp_w2 = nrm((N_MOE, N_EXPERTS, D_FF_EXPERT, D_MODEL), D_FF_EXPERT ** -0.5)
    final_norm = gain((D_MODEL,))
    return {"x": x, "c": c, "mix_norm": mix_norm, "mix_mod_w": mix_mod_w, "mix_mod_b": mix_mod_b,
            "w_in": w_in, "lru_conv_w": lru_conv_w, "lru_conv_b": lru_conv_b,
            "lru_wa": lru_wa, "lru_ba": lru_ba, "lru_wi": lru_wi, "lru_bi": lru_bi,
            "lru_lambda": lru_lambda, "sc_conv_w": sc_conv_w, "gn_lru": gn_lru, "gn_sc": gn_sc,
            "w_out": w_out, "ffn_norm": ffn_norm, "ffn_mod_w": ffn_mod_w, "ffn_mod_b": ffn_mod_b,
            "dense_w1": dense_w1, "dense_w3": dense_w3, "dense_w2": dense_w2,
            "router_w": router_w, "router_b": router_b,
            "exp_w1": exp_w1, "exp_w3": exp_w3, "exp_w2": exp_w2, "final_norm": final_norm}


def reference(x, c, mix_norm, mix_mod_w, mix_mod_b, w_in, lru_conv_w, lru_conv_b,
              lru_wa, lru_ba, lru_wi, lru_bi, lru_lambda, sc_conv_w, gn_lru, gn_sc, w_out,
              ffn_norm, ffn_mod_w, ffn_mod_b, dense_w1, dense_w3, dense_w2,
              router_w, router_b, exp_w1, exp_w3, exp_w2, final_norm):
    for l in range(DEPTH):
        shift, scale, gate = adaln(c, mix_mod_w[l], mix_mod_b[l])
        h = rms_norm(x, mix_norm[l]) * (1.0 + scale) + shift
        y = hybrid_mixer(h, w_in[l], lru_conv_w[l], lru_conv_b[l], lru_wa[l], lru_ba[l],
                         lru_wi[l], lru_bi[l], lru_lambda[l], sc_conv_w[l], gn_lru[l], gn_sc[l],
                         w_out[l])
        x = x + gate * y
        shift, scale, gate = adaln(c, ffn_mod_w[l], ffn_mod_b[l])
        h = rms_norm(x, ffn_norm[l]) * (1.0 + scale) + shift
        j = l // 2
        if l % 2 == 0:
            f = swiglu(h, dense_w1[j], dense_w3[j], dense_w2[j])
        else:
            f = moe_swiglu(h, router_w[j], router_b[j], exp_w1[j], exp_w3[j], exp_w2[j])
        x = x + gate * f
    return rms_norm(x, final_norm)
```

```cpp
#include <hip/hip_runtime.h>
#include <cstdio>
#include <cstdint>

namespace {
constexpr int D = 1024, BATCH = 4, SEQ = 4096, DEPTH = 4, M = BATCH * SEQ;
constexpr int DL = 512, DS = 512, HEADS = 8, HD = 64, DIN = 2560, DFF = 2816, NE = 8, DFE = 1408;
constexpr float EPS = 1e-6f;

__device__ __forceinline__ float sigmoidf_(float x) { return 1.f / (1.f + expf(-x)); }
__device__ __forceinline__ float siluf_(float x) { return x * sigmoidf_(x); }
__device__ __forceinline__ float geluf_(float x) { return 0.5f * x * (1.f + tanhf(0.7978845608028654f * (x + 0.044715f * x * x * x))); }
__device__ __forceinline__ float wave_sum(float v) {
#pragma unroll
    for (int o = 1; o < 64; o <<= 1) v += __shfl_xor(v, o);
    return v;
}

__global__ void __launch_bounds__(256) k_mod(const float* __restrict__ c, const float* __restrict__ W, const float* __restrict__ bias, float* __restrict__ mod) {
    const int j = blockIdx.x * 256 + threadIdx.x;
    float a0 = 0.f, a1 = 0.f, a2 = 0.f, a3 = 0.f;
    for (int k = 0; k < D; ++k) {
        const float w = W[(size_t)k * 3072 + j];
        a0 += siluf_(c[0 * D + k]) * w; a1 += siluf_(c[1 * D + k]) * w; a2 += siluf_(c[2 * D + k]) * w; a3 += siluf_(c[3 * D + k]) * w;
    }
    const float bb = bias[j];
    mod[0 * 3072 + j] = a0 + bb; mod[1 * 3072 + j] = a1 + bb; mod[2 * 3072 + j] = a2 + bb; mod[3 * 3072 + j] = a3 + bb;
}

__global__ void __launch_bounds__(256) k_norm(const float* x, const float* __restrict__ g, const float* __restrict__ mod, float* out) {
    const int row = blockIdx.x * 4 + (threadIdx.x >> 6), lane = threadIdx.x & 63, b = row / SEQ;
    float v[16]; float s = 0.f;
#pragma unroll
    for (int i = 0; i < 16; ++i) { v[i] = x[(size_t)row * D + i * 64 + lane]; s += v[i] * v[i]; }
    s = wave_sum(s);
    const float r = rsqrtf(s * (1.f / D) + EPS);
#pragma unroll
    for (int i = 0; i < 16; ++i) {
        const int col = i * 64 + lane;
        float y = v[i] * r * g[col];
        if (mod) y = y * (1.f + mod[b * 3072 + 1024 + col]) + mod[b * 3072 + col];
        out[(size_t)row * D + col] = y;
    }
}

template <int MODE>
__global__ void __launch_bounds__(256) k_gemm(const float* __restrict__ A, int lda, const float* __restrict__ B, int ldb, float* C, int ldc, int K,
                                              const float* __restrict__ gate, const float* __restrict__ rowscale, int rs_stride) {
    __shared__ float As[16][132];
    __shared__ float Bs[16][132];
    const int t = threadIdx.x, tx = t & 15, ty = t >> 4;
    const int row0 = blockIdx.y * 128, col0 = blockIdx.x * 128;
    float acc[8][8];
#pragma unroll
    for (int i = 0; i < 8; ++i)
#pragma unroll
        for (int j = 0; j < 8; ++j) acc[i][j] = 0.f;
    for (int k0 = 0; k0 < K; k0 += 16) {
#pragma unroll
        for (int i = 0; i < 2; ++i) {
            const int r = (t >> 2) + 64 * i, kc = (t & 3) * 4;
            const float4 a = *(const float4*)(A + (size_t)(row0 + r) * lda + k0 + kc);
            As[kc + 0][r] = a.x; As[kc + 1][r] = a.y; As[kc + 2][r] = a.z; As[kc + 3][r] = a.w;
            const int kr = (t >> 5) + 8 * i, cc = (t & 31) * 4;
            const float4 bv = *(const float4*)(B + (size_t)(k0 + kr) * ldb + col0 + cc);
            *(float4*)&Bs[kr][cc] = bv;
        }
        __syncthreads();
#pragma unroll
        for (int k = 0; k < 16; ++k) {
            const float4 a0 = *(const float4*)&As[k][ty * 4], a1 = *(const float4*)&As[k][64 + ty * 4];
            const float4 b0 = *(const float4*)&Bs[k][tx * 4], b1 = *(const float4*)&Bs[k][64 + tx * 4];
            const float av[8] = {a0.x, a0.y, a0.z, a0.w, a1.x, a1.y, a1.z, a1.w};
            const float bw[8] = {b0.x, b0.y, b0.z, b0.w, b1.x, b1.y, b1.z, b1.w};
#pragma unroll
            for (int i = 0; i < 8; ++i)
#pragma unroll
                for (int j = 0; j < 8; ++j) acc[i][j] += av[i] * bw[j];
        }
        __syncthreads();
    }
#pragma unroll
    for (int i = 0; i < 8; ++i) {
        const int row = row0 + (i < 4 ? ty * 4 + i : 64 + ty * 4 + (i - 4));
        const int b = row / SEQ;
        float rs = 1.f;
        if (MODE == 1 && rowscale) rs = rowscale[(size_t)row * rs_stride];
#pragma unroll
        for (int j = 0; j < 8; ++j) {
            const int col = col0 + (j < 4 ? tx * 4 + j : 64 + tx * 4 + (j - 4));
            float* p = C + (size_t)row * ldc + col;
            if (MODE == 0) *p = acc[i][j];
            else if (MODE == 2) *p = siluf_(*p) * acc[i][j];
            else *p = *p + gate[b * 3072 + col] * rs * acc[i][j];
        }
    }
}

__global__ void __launch_bounds__(256) k_lru_conv(const float* __restrict__ u, const float* __restrict__ w, const float* __restrict__ bconv, float* __restrict__ xc) {
    const int idx = blockIdx.x * 256 + threadIdx.x; const int m = idx / DL, c = idx % DL, t = m % SEQ;
    float s = bconv[c];
#pragma unroll
    for (int k = 0; k < 4; ++k) { const int tt = t - 3 + k; if (tt >= 0) s += w[k * DL + c] * u[(size_t)(m - 3 + k) * DIN + c]; }
    xc[idx] = s;
}
__global__ void __launch_bounds__(256) k_lru_gates(const float* __restrict__ xc, const float* __restrict__ wa, const float* __restrict__ ba, const float* __restrict__ wi,
                                                   const float* __restrict__ bi, const float* __restrict__ lam, float* __restrict__ av, float* __restrict__ uv) {
    const int idx = blockIdx.x * 256 + threadIdx.x; const int m = idx / DL, c = idx % DL, h = c / HD, j = c % HD;
    float r = ba[c], ig = bi[c];
    const float* xr = xc + (size_t)m * DL + h * HD;
    for (int i = 0; i < HD; ++i) { const float xv = xr[i]; r += xv * wa[(h * HD + i) * HD + j]; ig += xv * wi[(h * HD + i) * HD + j]; }
    r = sigmoidf_(r); ig = sigmoidf_(ig);
    const float sp = log1pf(expf(-lam[c]));
    const float log_a = -8.0f * r * sp;
    av[idx] = expf(log_a);
    uv[idx] = sqrtf(-expm1f(2.0f * log_a)) * (ig * xc[idx]);
}
__global__ void __launch_bounds__(64) k_scan(const float* __restrict__ av, float* uv) {
    const int idx = blockIdx.x * 64 + threadIdx.x; const int b = idx / DL, c = idx % DL;
    float h = 0.f;
    for (int t = 0; t < SEQ; t += 8) {
        float a[8], u[8];
#pragma unroll
        for (int q = 0; q < 8; ++q) { const size_t o = (size_t)(b * SEQ + t + q) * DL + c; a[q] = av[o]; u[q] = uv[o]; }
#pragma unroll
        for (int q = 0; q < 8; ++q) { h = a[q] * h + u[q]; uv[(size_t)(b * SEQ + t + q) * DL + c] = h; }
    }
}
__global__ void __launch_bounds__(256) k_mix_out(const float* __restrict__ u, const float* __restrict__ hs, const float* __restrict__ scw, const float* __restrict__ gn_lru,
                                                 const float* __restrict__ gn_sc, float* __restrict__ y) {
    const int wv = blockIdx.x * 4 + (threadIdx.x >> 6), lane = threadIdx.x & 63; const int m = wv / 16, g = wv % 16, t = m % SEQ;
    float val, gain;
    if (g < 8) {
        const int c = g * HD + lane;
        val = geluf_(u[(size_t)m * DIN + DL + c]) * hs[(size_t)m * DL + c]; gain = gn_lru[c];
    } else {
        const int c = (g - 8) * HD + lane;
        float s = 0.f;
#pragma unroll
        for (int k = 0; k < 3; ++k) { const int tt = t - 2 + k; if (tt >= 0) { const float* ur = u + (size_t)(m - 2 + k) * DIN; s += scw[k * DS + c] * (ur[1536 + c] * ur[2048 + c]); } }
        val = u[(size_t)m * DIN + 1024 + c] * s; gain = gn_sc[c];
    }
    const float ss = wave_sum(val * val);
    y[(size_t)m * D + g * HD + lane] = val * rsqrtf(ss * (1.f / HD) + EPS) * gain;
}
__global__ void __launch_bounds__(256) k_router(const float* __restrict__ h, const float* __restrict__ wr, const float* __restrict__ br, float* __restrict__ comb) {
    const int row = blockIdx.x * 4 + (threadIdx.x >> 6), lane = threadIdx.x & 63;
    float lg[8];
#pragma unroll
    for (int e = 0; e < 8; ++e) lg[e] = 0.f;
    for (int i = 0; i < 16; ++i) { const int k = i * 64 + lane; const float hv = h[(size_t)row * D + k];
#pragma unroll
        for (int e = 0; e < 8; ++e) lg[e] += hv * wr[k * 8 + e]; }
#pragma unroll
    for (int e = 0; e < 8; ++e) lg[e] = wave_sum(lg[e]) + br[e];
    int i1 = 0; float v1 = lg[0];
#pragma unroll
    for (int e = 1; e < 8; ++e) if (lg[e] > v1) { v1 = lg[e]; i1 = e; }
    int i2 = -1; float v2 = -3.0e38f;
#pragma unroll
    for (int e = 0; e < 8; ++e) if (e != i1 && lg[e] > v2) { v2 = lg[e]; i2 = e; }
    const float e2 = expf(v2 - v1), w1 = 1.f / (1.f + e2), w2 = e2 / (1.f + e2);
    if (lane < 8) comb[(size_t)row * 8 + lane] = (lane == i1) ? w1 : ((lane == i2) ? w2 : 0.f);
}
}

extern "C" void kernel_launch(void* const* d_in, const int* in_sizes, int n_in, void* d_out, int out_size, void* d_ws, size_t ws_size, hipStream_t stream) {
    const float* x_in = (const float*)d_in[0]; const float* c = (const float*)d_in[1];
    const float* mix_norm = (const float*)d_in[2]; const float* mix_mod_w = (const float*)d_in[3]; const float* mix_mod_b = (const float*)d_in[4];
    const float* w_in = (const float*)d_in[5]; const float* lru_conv_w = (const float*)d_in[6]; const float* lru_conv_b = (const float*)d_in[7];
    const float* lru_wa = (const float*)d_in[8]; const float* lru_ba = (const float*)d_in[9]; const float* lru_wi = (const float*)d_in[10]; const float* lru_bi = (const float*)d_in[11];
    const float* lru_lambda = (const float*)d_in[12]; const float* sc_conv_w = (const float*)d_in[13]; const float* gn_lru = (const float*)d_in[14]; const float* gn_sc = (const float*)d_in[15];
    const float* w_out = (const float*)d_in[16]; const float* ffn_norm = (const float*)d_in[17]; const float* ffn_mod_w = (const float*)d_in[18]; const float* ffn_mod_b = (const float*)d_in[19];
    const float* dense_w1 = (const float*)d_in[20]; const float* dense_w3 = (const float*)d_in[21]; const float* dense_w2 = (const float*)d_in[22];
    const float* router_w = (const float*)d_in[23]; const float* router_b = (const float*)d_in[24];
    const float* exp_w1 = (const float*)d_in[25]; const float* exp_w3 = (const float*)d_in[26]; const float* exp_w2 = (const float*)d_in[27]; const float* final_norm = (const float*)d_in[28];
    float* x = (float*)d_out;
    float* ws = (float*)d_ws;
    size_t off = 0;
    float* mod = ws + off; off += 4 * 3072;
    float* comb = ws + off; off += (size_t)M * 8;
    float* hb = ws + off; off += (size_t)M * D;
    float* big = ws + off; off += (size_t)M * DFF;
    float* xc = ws + off; off += (size_t)M * DL;
    float* av = ws + off; off += (size_t)M * DL;
    float* uv = ws + off; off += (size_t)M * DL;
    if (off * 4 > ws_size) { fprintf(stderr, "workspace too small: need %zu have %zu\n", off * 4, ws_size); return; }

    hipMemcpyAsync(x, x_in, (size_t)M * D * 4, hipMemcpyDeviceToDevice, stream);
    for (int l = 0; l < DEPTH; ++l) {
        k_mod<<<12, 256, 0, stream>>>(c, mix_mod_w + (size_t)l * D * 3072, mix_mod_b + l * 3072, mod);
        k_norm<<<M / 4, 256, 0, stream>>>(x, mix_norm + l * D, mod, hb);
        k_gemm<0><<<dim3(DIN / 128, M / 128), 256, 0, stream>>>(hb, D, w_in + (size_t)l * D * DIN, DIN, big, DIN, D, nullptr, nullptr, 0);
        k_lru_conv<<<M * DL / 256, 256, 0, stream>>>(big, lru_conv_w + l * 4 * DL, lru_conv_b + l * DL, xc);
        k_lru_gates<<<M * DL / 256, 256, 0, stream>>>(xc, lru_wa + (size_t)l * HEADS * HD * HD, lru_ba + l * DL, lru_wi + (size_t)l * HEADS * HD * HD, lru_bi + l * DL, lru_lambda + l * DL, av, uv);
        k_scan<<<BATCH * DL / 64, 64, 0, stream>>>(av, uv);
        k_mix_out<<<M * 16 / 4, 256, 0, stream>>>(big, uv, sc_conv_w + l * 3 * DS, gn_lru + l * DL, gn_sc + l * DS, hb);
        k_gemm<1><<<dim3(D / 128, M / 128), 256, 0, stream>>>(hb, D, w_out + (size_t)l * D * D, D, x, D, D, mod + 2048, nullptr, 0);
        k_mod<<<12, 256, 0, stream>>>(c, ffn_mod_w + (size_t)l * D * 3072, ffn_mod_b + l * 3072, mod);
        k_norm<<<M / 4, 256, 0, stream>>>(x, ffn_norm + l * D, mod, hb);
        const int j = l / 2;
        if (l % 2 == 0) {
            k_gemm<0><<<dim3(DFF / 128, M / 128), 256, 0, stream>>>(hb, D, dense_w1 + (size_t)j * D * DFF, DFF, big, DFF, D, nullptr, nullptr, 0);
            k_gemm<2><<<dim3(DFF / 128, M / 128), 256, 0, stream>>>(hb, D, dense_w3 + (size_t)j * D * DFF, DFF, big, DFF, D, nullptr, nullptr, 0);
            k_gemm<1><<<dim3(D / 128, M / 128), 256, 0, stream>>>(big, DFF, dense_w2 + (size_t)j * DFF * D, D, x, D, DFF, mod + 2048, nullptr, 0);
        } else {
            k_router<<<M / 4, 256, 0, stream>>>(hb, router_w + (size_t)j * D * NE, router_b + j * NE, comb);
            for (int e = 0; e < NE; ++e) {
                const size_t we = (size_t)(j * NE + e) * D * DFE;
                k_gemm<0><<<dim3(DFE / 128, M / 128), 256, 0, stream>>>(hb, D, exp_w1 + we, DFE, big, DFE, D, nullptr, nullptr, 0);
                k_gemm<2><<<dim3(DFE / 128, M / 128), 256, 0, stream>>>(hb, D, exp_w3 + we, DFE, big, DFE, D, nullptr, nullptr, 0);
                k_gemm<1><<<dim3(D / 128, M / 128), 256, 0, stream>>>(big, DFE, exp_w2 + we, D, x, D, DFE, mod + 2048, comb + e, NE);
            }
        }
    }
    k_norm<<<M / 4, 256, 0, stream>>>(x, final_norm, nullptr, x);
}
```

```cpp
#include <hip/hip_runtime.h>
#include <cstdio>
#include <cstdint>

#ifndef MK_SINGLE
#define MK_SINGLE 1
#endif

#define LAS __attribute__((address_space(3)))
#define GAS __attribute__((address_space(1)))
#define RLX_AGENT __ATOMIC_RELAXED, __HIP_MEMORY_SCOPE_AGENT

namespace {
typedef unsigned short bf16_t;
typedef short bf16x8 __attribute__((ext_vector_type(8)));
typedef float f32x4 __attribute__((ext_vector_type(4)));
typedef float f32x2 __attribute__((ext_vector_type(2)));
typedef unsigned u32x4 __attribute__((ext_vector_type(4)));
typedef unsigned u32x2 __attribute__((ext_vector_type(2)));
typedef int i32x4 __attribute__((ext_vector_type(4)));

constexpr int D = 1024, BATCH = 4, SEQ = 4096, DEPTH = 4, M = BATCH * SEQ;
constexpr int DL = 512, DS = 512, HEADS = 8, HD = 64, DIN = 2560, DFF = 2816, NE = 8, DFE = 1408;
constexpr float EPS = 1e-6f;
constexpr int NWAVES = 8, NTHREADS = 512;
constexpr int MOE_ROWS = 34816;

constexpr size_t MiB = 1u << 20;
constexpr size_t WS_CTL = 0, CTL_ZERO_BYTES = 1 * MiB;
constexpr size_t WS_MOD = 1 * MiB;
constexpr size_t WS_TOK = 2 * MiB;
constexpr size_t WS_LIST = 3 * MiB;
constexpr size_t WS_WIN = 8 * MiB;
constexpr size_t WS_WOUT = 28 * MiB;
constexpr size_t WS_W13D = 36 * MiB;
constexpr size_t WS_W2D = 58 * MiB;
constexpr size_t WS_W13E = 69 * MiB;
constexpr size_t WS_W2E = 157 * MiB;
constexpr size_t WS_HB = 201 * MiB;
constexpr size_t WS_YB = 233 * MiB;
constexpr size_t WS_U = 265 * MiB;
constexpr size_t WS_YS = 359 * MiB;
constexpr size_t WS_END = 495 * MiB;
static_assert(WS_WIN + (size_t)4 * DIN * D * 2 <= WS_WOUT && WS_WOUT + (size_t)4 * D * D * 2 <= WS_W13D && WS_W13D + (size_t)2 * 2 * DFF * D * 2 <= WS_W2D &&
              WS_W2D + (size_t)2 * D * DFF * 2 <= WS_W13E && WS_W13E + (size_t)16 * 2 * DFE * D * 2 <= WS_W2E && WS_W2E + (size_t)16 * D * DFE * 2 <= WS_HB &&
              WS_U + (size_t)MOE_ROWS * DFE * 2 <= WS_YS && WS_U + (size_t)M * DFF * 2 <= WS_YS && WS_YS + (size_t)MOE_ROWS * D * 4 <= WS_END, "ws map");
constexpr int CW_TMO = 0;
constexpr int CW_BAR = 4096;
constexpr int CW_CNT = 8192;

constexpr int RING_BYTES = 131072;
constexpr int LDS_BYTES = 147456;
constexpr int MISC_OFF = LDS_BYTES - 256;

struct Args { const float* in[29]; float* out; unsigned char* ws; int ph_lo, ph_hi; };

__device__ __forceinline__ unsigned cvt_pk_bf16(float lo, float hi) { unsigned r; asm volatile("v_cvt_pk_bf16_f32 %0, %1, %2" : "=v"(r) : "v"(lo), "v"(hi)); return r; }
__device__ __forceinline__ float bf2f(unsigned short h) { return __uint_as_float((unsigned)h << 16); }
__device__ __forceinline__ float wave_sum(float v) {
#pragma unroll
    for (int o = 1; o < 64; o <<= 1) v += __shfl_xor(v, o);
    return v;
}
__device__ __forceinline__ float sigmoidf_(float x) { return 1.f / (1.f + __expf(-x)); }
__device__ __forceinline__ float silu_fast(float x) { return x * __builtin_amdgcn_rcpf(1.f + __builtin_amdgcn_exp2f(-1.4426950408889634f * x)); }
__device__ __forceinline__ float geluf_(float x) { return 0.5f * x * (1.f + tanhf(0.7978845608028654f * (x + 0.044715f * x * x * x))); }
__device__ __forceinline__ unsigned ld_agent(const unsigned* p) { return __hip_atomic_load((unsigned*)p, RLX_AGENT); }

#define XB_TMO      128
#define XB_XCNT(j)  (256  + 64 * (j))
#define XB_XSUB(j)  (1280 + 64 * (j))
#define XB_XGEN(j)  (2304 + 64 * (j))
#define XB_TOP      3328
#define XB_TOPGEN   3392
#define XCD_BAR_WORDS 3456
#define XB_SPIN_CAP (1u << 18)
__device__ __forceinline__ unsigned xb_ld(unsigned* p)              { return __hip_atomic_load(p, __ATOMIC_RELAXED, __HIP_MEMORY_SCOPE_AGENT); }
__device__ __forceinline__ unsigned xb_add(unsigned* p, unsigned v) { return __hip_atomic_fetch_add(p, v, __ATOMIC_RELAXED, __HIP_MEMORY_SCOPE_AGENT); }
__device__ __forceinline__ unsigned xb_xcc_id() { return (unsigned)__builtin_amdgcn_s_getreg((3 << 11) | 20) & 0xFu; }
#define XB_SPIN(cond, bar) do { unsigned _sp = 0; while (cond) { __builtin_amdgcn_s_sleep(1); \
    if ((++_sp & 255u) == 0u) { if (xb_ld(&(bar)[XB_TMO])) break; if (_sp > XB_SPIN_CAP) { atomicAdd(&(bar)[XB_TMO], 1u); break; } } } } while (0)
struct XcdBarrier { unsigned* bar; unsigned x; volatile LAS unsigned* st; };
__device__ __forceinline__ XcdBarrier xcd_barrier_post(unsigned* bar, volatile LAS unsigned* st) {
    XcdBarrier b; b.bar = bar; b.x = xb_xcc_id(); b.st = st;
    if (threadIdx.x == 0) (void)xb_add(&bar[XB_XCNT(b.x)], 1u);
    return b;
}
__device__ __forceinline__ void xcd_barrier_complete(unsigned* bar, unsigned x, unsigned& nloc, unsigned& nx) {
    const unsigned G = gridDim.x * gridDim.y * gridDim.z;
    unsigned sum, cnt, mine, sp = 0u;
    for (;;) {
        sum = 0u; cnt = 0u; mine = 0u;
#pragma unroll
        for (unsigned j = 0; j < 16; ++j) { const unsigned c = xb_ld(&bar[XB_XCNT(j)]); sum += c; cnt += (c > 0u) ? 1u : 0u; mine = (j == x) ? c : mine; }
        if (sum == G) break;
        __builtin_amdgcn_s_sleep(1);
        if ((++sp & 255u) == 0u) { if (xb_ld(&bar[XB_TMO])) break; if (sp > XB_SPIN_CAP) { atomicAdd(&bar[XB_TMO], 1u); break; } }
    }
    nloc = mine > 0u ? mine : 1u; nx = cnt > 0u ? cnt : 1u;
}
__device__ __forceinline__ void xcd_barrier(const XcdBarrier& b) {
    asm volatile("s_waitcnt vmcnt(0)" ::: "memory");
    __syncthreads();
    if (threadIdx.x == 0) {
        unsigned* bar = b.bar;
        __builtin_amdgcn_s_waitcnt(0);
        unsigned nloc = b.st[0], nx = b.st[1];
        if (nloc == 0u) { xcd_barrier_complete(bar, b.x, nloc, nx); b.st[0] = nloc; b.st[1] = nx; }
        const unsigned old = xb_add(&bar[XB_XSUB(b.x)], 1u);
        const unsigned gen = old / nloc;
        if (old + 1u == (gen + 1u) * nloc) {
            __builtin_amdgcn_fence(__ATOMIC_RELEASE, "agent");
            asm volatile("s_waitcnt vmcnt(0)" ::: "memory");
            const unsigned og = xb_add(&bar[XB_TOP], 1u);
            const unsigned tg = og / nx;
            if (og + 1u == (tg + 1u) * nx) xb_add(&bar[XB_TOPGEN], 1u);
            else XB_SPIN(xb_ld(&bar[XB_TOPGEN]) == tg, bar);
            __builtin_amdgcn_fence(__ATOMIC_ACQUIRE, "agent");
            xb_add(&bar[XB_XGEN(b.x)], 1u);
            asm volatile("s_waitcnt vmcnt(0)" ::: "memory");
        } else {
            XB_SPIN(xb_ld(&bar[XB_XGEN(b.x)]) == gen, bar);
            __builtin_amdgcn_fence(__ATOMIC_ACQUIRE, "agent");
            asm volatile("s_waitcnt vmcnt(0)" ::: "memory");
        }
    }
    __syncthreads();
}

namespace pg8 {
constexpr int BM = 256, BK = 64, HALF = 128, HTB = HALF * BK * 2, STAGE_BYTES = 8 * HTB, NXCD = 8, WGM = 8;
__host__ __device__ __forceinline__ int lds_byte(int r, int c) { const int st = (r >> 4) * 2 + (c >> 5), rr = r & 15, cc = c & 31, ob = rr * 64 + cc * 2; return st * 1024 + (ob ^ (((ob >> 9) & 1) << 5)); }
__host__ __device__ __forceinline__ void stage_rc(int b, int& R, int& C) { const int st = b / 1024, sb = b % 1024, swz = sb ^ (((sb >> 9) & 1) << 5); R = (st >> 1) * 16 + swz / 64; C = (st & 1) * 32 + (swz % 64) / 2; }
__host__ __device__ __forceinline__ int perm32(int rho) { const int n = rho >> 4, i = rho & 15; return 8 * (i >> 2) + 4 * n + (i & 3); }
struct Unit { int pm, pn; };
struct Gemm { const bf16_t* A; const bf16_t* Bt; int K; };

struct StaticOrder {
    int nM, nN, nwg, G, c;
    __device__ void init(int nM_, int nN_, int G_, int c_) { nM = nM_; nN = nN_; nwg = nM * nN; G = G_; c = c_; }
    __device__ bool next(int i, Unit& u) const {
        const long L = (long)i * G + c; if (L >= nwg) return false;
        int wgid = (int)L; { const int q = nwg / NXCD, r = nwg % NXCD, xcd = wgid % NXCD, off = wgid / NXCD; wgid = (xcd < r ? xcd * (q + 1) : r * (q + 1) + (xcd - r) * q) + off; }
        const int nig = WGM * nN, gid = wgid / nig, fm = gid * WGM, gsz = (nM - fm) < WGM ? (nM - fm) : WGM;
        u.pm = fm + ((wgid % nig) % gsz); u.pn = (wgid % nig) / gsz; return true;
    }
};
struct DenseOrder : StaticOrder {
    unsigned rowbytes;
    __device__ __forceinline__ unsigned a_off(const Unit& u, int r) const { return (unsigned)(u.pm * BM + r) * rowbytes; }
    __device__ __forceinline__ int b_tile(const Unit& u) const { return u.pn; }
};
struct MoeOrder : StaticOrder {
    unsigned rowbytes; int toff[9]; int cnt[8]; const int* list; bool gather;
    __device__ __forceinline__ void expert_of(int pm, int& e, int& t0, int& c) const {
        e = 0; t0 = 0; c = cnt[0];
#pragma unroll
        for (int j = 1; j < 8; ++j) if (pm >= toff[j]) { e = j; t0 = toff[j]; c = cnt[j]; }
    }
    __device__ __forceinline__ unsigned a_off(const Unit& u, int r) const {
        if (!gather) return (unsigned)(u.pm * BM + r) * rowbytes;
        int e, t0, c; expert_of(u.pm, e, t0, c);
        int p = (u.pm - t0) * BM + r; p = p < c ? p : c - 1;
        const int tok = list[e * M + p];
        return (unsigned)tok * rowbytes;
    }
    __device__ __forceinline__ int b_tile(const Unit& u) const { int e, t0, c; expert_of(u.pm, e, t0, c); return e * nN + u.pn; }
};

struct EpiBf16 {
    static constexpr bool PERM = true;
    bf16_t* O; int ldc;
    __device__ __forceinline__ void operator()(const f32x4 (&acc)[2][2][4][2], const Unit& u, int wr, int wc, int fr, int fq) const {
        const int row0 = u.pm * BM + wr * 64 + fr, col0 = u.pn * BM + wc * 32 + 8 * fq;
#pragma unroll
        for (int ai = 0; ai < 2; ++ai)
#pragma unroll
            for (int m = 0; m < 4; ++m) { bf16_t* rowp = O + (size_t)(row0 + ai * HALF + m * 16) * ldc + col0;
#pragma unroll
                for (int bj = 0; bj < 2; ++bj) { const f32x4 v0 = acc[ai][bj][m][0], v1 = acc[ai][bj][m][1];
                    u32x4 w; w.x = cvt_pk_bf16(v0[0], v0[1]); w.y = cvt_pk_bf16(v0[2], v0[3]); w.z = cvt_pk_bf16(v1[0], v1[1]); w.w = cvt_pk_bf16(v1[2], v1[3]);
                    *(u32x4*)(rowp + bj * HALF) = w; } }
    }
};
struct EpiSwiGLU {
    static constexpr bool PERM = true;
    bf16_t* H; int ldh;
    __device__ __forceinline__ void operator()(const f32x4 (&acc)[2][2][4][2], const Unit& u, int wr, int wc, int fr, int fq) const {
        const int row0 = u.pm * BM + wr * 64 + fr, col0 = u.pn * HALF + wc * 32 + 8 * fq;
#pragma unroll
        for (int ai = 0; ai < 2; ++ai)
#pragma unroll
            for (int m = 0; m < 4; ++m) { bf16_t* rowp = H + (size_t)(row0 + ai * HALF + m * 16) * ldh + col0;
                float o[8];
#pragma unroll
                for (int n = 0; n < 2; ++n)
#pragma unroll
                    for (int q = 0; q < 4; ++q) o[n * 4 + q] = silu_fast(acc[ai][0][m][n][q]) * acc[ai][1][m][n][q];
                u32x4 w; w.x = cvt_pk_bf16(o[0], o[1]); w.y = cvt_pk_bf16(o[2], o[3]); w.z = cvt_pk_bf16(o[4], o[5]); w.w = cvt_pk_bf16(o[6], o[7]);
                *(u32x4*)rowp = w; }
    }
};
struct EpiRes {
    static constexpr bool PERM = false;
    const float* xsrc; float* xdst; const float* gate;
    __device__ __forceinline__ void operator()(const f32x4 (&acc)[2][2][4][2], const Unit& u, int wr, int wc, int fr, int fq) const {
        const int row0 = u.pm * BM + wr * 64 + fr, col0 = u.pn * BM + wc * 32 + 4 * fq, b = (u.pm * BM) / SEQ;
        f32x4 gv[2][2];
#pragma unroll
        for (int bj = 0; bj < 2; ++bj)
#pragma unroll
            for (int n = 0; n < 2; ++n) gv[bj][n] = *(const f32x4*)(gate + b * 3072 + col0 + bj * HALF + n * 16);
#pragma unroll
        for (int ai = 0; ai < 2; ++ai)
#pragma unroll
            for (int m = 0; m < 4; ++m) { const size_t off = (size_t)(row0 + ai * HALF + m * 16) * D + col0;
#pragma unroll
                for (int bj = 0; bj < 2; ++bj)
#pragma unroll
                    for (int n = 0; n < 2; ++n) { const f32x4 xs = *(const f32x4*)(xsrc + off + bj * HALF + n * 16); *(f32x4*)(xdst + off + bj * HALF + n * 16) = xs + gv[bj][n] * acc[ai][bj][m][n]; }
                if (m & 1) asm volatile("" ::: "memory"); }
    }
};
struct EpiF32 {
    static constexpr bool PERM = false;
    float* C; int ldc;
    __device__ __forceinline__ void operator()(const f32x4 (&acc)[2][2][4][2], const Unit& u, int wr, int wc, int fr, int fq) const {
        const int row0 = u.pm * BM + wr * 64 + fr, col0 = u.pn * BM + wc * 32 + 4 * fq;
#pragma unroll
        for (int ai = 0; ai < 2; ++ai)
#pragma unroll
            for (int m = 0; m < 4; ++m) { float* rowp = C + (size_t)(row0 + ai * HALF + m * 16) * ldc + col0;
#pragma unroll
                for (int bj = 0; bj < 2; ++bj)
#pragma unroll
                    for (int n = 0; n < 2; ++n) *(f32x4*)(rowp + bj * HALF + n * 16) = acc[ai][bj][m][n]; }
    }
};

template <class Epi, class Sched>
__device__ __forceinline__ void gemm_phase(LAS unsigned char* lds, const Gemm g, const Sched& S, const Epi& E) {
    int tid_ = threadIdx.x; asm volatile("" : "+v"(tid_));
    const int tid = tid_, wid = __builtin_amdgcn_readfirstlane(tid >> 6), lane = tid & 63, wr = wid >> 2, wc = wid & 3, fr = lane & 15, fq = lane >> 4;
    const int K = g.K, nt = K / BK;
    unsigned voffB[2];
#pragma unroll
    for (int i = 0; i < 2; ++i) { int R, C; stage_rc(tid * 16 + i * 8192, R, C); const int Rb = Epi::PERM ? ((R & ~31) + perm32(R & 31)) : R; voffB[i] = (unsigned)(Rb * K + C) * 2u; }
    const size_t kstep = (size_t)(BK * 2);
    const size_t hstep = (size_t)HALF * K * 2;
    const size_t tstep = 2 * hstep;
    const unsigned ldsw = (unsigned)wid * 1024u;
    const int aoff = lds_byte(wr * 64 + fr, fq * 8), boff = lds_byte(wc * 32 + fr, fq * 8);
#define PG8_SA(b, h) (((b) * 2 + (h)) * HTB)
#define PG8_SB(b, h) ((4 + (b) * 2 + (h)) * HTB)
#define PG8_STAGE(bufoff, gbase, voff) do { _Pragma("unroll") for (int _i = 0; _i < 2; ++_i) \
        __builtin_amdgcn_global_load_lds((const unsigned*)((const char*)(gbase) + (voff)[_i]), (LAS unsigned*)(lds + (bufoff) + ldsw + _i * 8192), 16, 0, 0); } while (0)
#define PG8_LDA(dst, b, h) do { _Pragma("unroll") for (int m = 0; m < 4; ++m) _Pragma("unroll") for (int k = 0; k < 2; ++k) dst[m][k] = *(const LAS bf16x8*)(lds + PG8_SA(b, h) + aoff + m * 2048 + k * 1024); } while (0)
#define PG8_LDB(dst, b, h) do { _Pragma("unroll") for (int n = 0; n < 2; ++n) _Pragma("unroll") for (int k = 0; k < 2; ++k) dst[n][k] = *(const LAS bf16x8*)(lds + PG8_SB(b, h) + boff + n * 2048 + k * 1024); } while (0)
#define PG8_MMA(ai, bj, At, Bt) do { __builtin_amdgcn_s_setprio(1); _Pragma("unroll") for (int m = 0; m < 4; ++m) _Pragma("unroll") for (int n = 0; n < 2; ++n) _Pragma("unroll") for (int k = 0; k < 2; ++k) \
        acc[ai][bj][m][n] = __builtin_amdgcn_mfma_f32_16x16x32_bf16(Bt[n][k], At[m][k], acc[ai][bj][m][n], 0, 0, 0); __builtin_amdgcn_s_setprio(0); } while (0)
#define PG8_WAIT_V(n) asm volatile("s_waitcnt vmcnt(" #n ")" ::: "memory")
#define PG8_WAIT_L(n) asm volatile("s_waitcnt lgkmcnt(" #n ")" ::: "memory")
#define PG8_BAR __builtin_amdgcn_s_barrier()
#define PG8_SCHED __builtin_amdgcn_sched_barrier(0)
    Unit cur, nxt; int ui = 0;
    if (!S.next(0, cur)) return;
    f32x4 acc[2][2][4][2];
#pragma unroll
    for (int a = 0; a < 2; ++a)
#pragma unroll
        for (int b = 0; b < 2; ++b)
#pragma unroll
            for (int m = 0; m < 4; ++m)
#pragma unroll
                for (int n = 0; n < 2; ++n) acc[a][b][m][n] = (f32x4){0.f, 0.f, 0.f, 0.f};
    bf16x8 At[4][2], B0[2][2], B1[2][2];
    unsigned oc0[2], oc1[2];
#pragma unroll
    for (int i = 0; i < 2; ++i) { int R, C; stage_rc(tid * 16 + i * 8192, R, C); oc0[i] = S.a_off(cur, R) + (unsigned)C * 2u; oc1[i] = S.a_off(cur, HALF + R) + (unsigned)C * 2u; }
    const char* Ab = (const char*)g.A;
    const char* cB = (const char*)g.Bt + (size_t)S.b_tile(cur) * tstep;
    PG8_STAGE(PG8_SB(0, 0), cB, voffB); PG8_STAGE(PG8_SB(0, 1), cB + hstep, voffB); PG8_STAGE(PG8_SA(0, 0), Ab, oc0); PG8_STAGE(PG8_SA(0, 1), Ab, oc1);
    if (wr == 1) PG8_BAR;
    PG8_WAIT_V(2); PG8_BAR;
    PG8_STAGE(PG8_SB(1, 0), cB + kstep, voffB); PG8_STAGE(PG8_SA(1, 0), Ab + kstep, oc0); PG8_STAGE(PG8_SB(1, 1), cB + hstep + kstep, voffB);
    PG8_WAIT_V(6); PG8_BAR;
    for (;;) {
        const bool has_next = S.next(ui + 1, nxt);
        const char* nB = has_next ? (const char*)g.Bt + (size_t)S.b_tile(nxt) * tstep : cB;
        for (int t = 0; t < nt; t += 2) {
            const bool last = (t == nt - 2);
            const char* a1 = Ab + (size_t)(t + 1) * kstep;
            const char* a2 = last ? Ab : Ab + (size_t)(t + 2) * kstep; const char* b2 = last ? nB : cB + (size_t)(t + 2) * kstep;
            const char* a3 = a2 + kstep; const char* b3 = b2 + kstep;
            PG8_LDB(B0, 0, 0); PG8_LDB(B1, 0, 1); PG8_SCHED; PG8_LDA(At, 0, 0); PG8_STAGE(PG8_SA(1, 1), a1, oc1);
            if (last && has_next) {
#pragma unroll
                for (int i = 0; i < 2; ++i) { int R, C; stage_rc(tid * 16 + i * 8192, R, C); oc0[i] = S.a_off(nxt, R) + (unsigned)C * 2u; oc1[i] = S.a_off(nxt, HALF + R) + (unsigned)C * 2u; }
            }
            PG8_WAIT_V(8); PG8_WAIT_L(0); PG8_BAR; PG8_MMA(0, 0, At, B0); PG8_MMA(0, 1, At, B1); PG8_BAR; PG8_SCHED;
            PG8_LDA(At, 0, 1); PG8_STAGE(PG8_SB(0, 0), b2, voffB); PG8_STAGE(PG8_SB(0, 1), b2 + hstep, voffB); PG8_STAGE(PG8_SA(0, 0), a2, oc0);
            PG8_WAIT_V(8); PG8_WAIT_L(0); PG8_BAR; PG8_MMA(1, 0, At, B0); PG8_MMA(1, 1, At, B1); PG8_BAR; PG8_SCHED;
            PG8_LDB(B0, 1, 0); PG8_LDB(B1, 1, 1); PG8_SCHED; PG8_LDA(At, 1, 0); PG8_STAGE(PG8_SA(0, 1), a2, oc1);
            PG8_WAIT_V(8); PG8_WAIT_L(0); PG8_BAR; PG8_MMA(0, 0, At, B0); PG8_MMA(0, 1, At, B1); PG8_BAR; PG8_SCHED;
            PG8_LDA(At, 1, 1); PG8_STAGE(PG8_SB(1, 0), b3, voffB); PG8_STAGE(PG8_SB(1, 1), b3 + hstep, voffB); PG8_STAGE(PG8_SA(1, 0), a3, oc0);
            PG8_WAIT_V(8); PG8_WAIT_L(0); PG8_BAR; PG8_MMA(1, 0, At, B0); PG8_MMA(1, 1, At, B1); PG8_BAR; PG8_SCHED;
        }
        if (wr == 0) PG8_BAR;
        E(acc, cur, wr, wc, fr, fq);
        if (!has_next) break;
#pragma unroll
        for (int a = 0; a < 2; ++a)
#pragma unroll
            for (int b = 0; b < 2; ++b)
#pragma unroll
                for (int m = 0; m < 4; ++m)
#pragma unroll
                    for (int n = 0; n < 2; ++n) acc[a][b][m][n] = (f32x4){0.f, 0.f, 0.f, 0.f};
        cur = nxt; cB = nB; ++ui;
        if (wr == 1) PG8_BAR;
    }
    PG8_WAIT_V(0);
    PG8_BAR;
#undef PG8_SA
#undef PG8_SB
#undef PG8_STAGE
#undef PG8_LDA
#undef PG8_LDB
#undef PG8_MMA
#undef PG8_WAIT_V
#undef PG8_WAIT_L
#undef PG8_BAR
#undef PG8_SCHED
}
}

struct Frame {
    LAS unsigned char* lds; volatile LAS unsigned* MISC; unsigned* ctl;
    int tid, lane, wave, vcu, G;
};

__device__ __forceinline__ void transpose_item(const float* __restrict__ W, int ldw, int K, int k0, int n0, bf16_t* WT, int drow0, LAS float* scr, int lane) {
#pragma unroll 8
    for (int kk = 0; kk < 64; ++kk) scr[kk * 65 + lane] = W[(size_t)(k0 + kk) * ldw + n0 + lane];
    asm volatile("s_waitcnt lgkmcnt(0)" ::: "memory");
    const int c = lane & 7;
#pragma unroll
    for (int j = 0; j < 8; ++j) { const int n = (lane >> 3) + 8 * j; const LAS float* s = scr + (8 * c) * 65 + n;
        u32x4 o; o.x = cvt_pk_bf16(s[0 * 65], s[1 * 65]); o.y = cvt_pk_bf16(s[2 * 65], s[3 * 65]); o.z = cvt_pk_bf16(s[4 * 65], s[5 * 65]); o.w = cvt_pk_bf16(s[6 * 65], s[7 * 65]);
        *(u32x4*)(WT + (size_t)(drow0 + n) * K + k0 + 8 * c) = o; }
    asm volatile("s_waitcnt lgkmcnt(0)" ::: "memory");
}
__device__ __forceinline__ void phase_prologue(const Args& a, Frame& F0) {
    Frame F = F0; asm volatile("" : "+v"(F.tid), "+v"(F.lane));
    const float* c = a.in[1];
    float* mod = (float*)(a.ws + WS_MOD);
    LAS float* sc = (LAS float*)(F.lds);
    LAS float* red = (LAS float*)(F.lds + 16384);
    for (int i = F.tid; i < 4 * D; i += NTHREADS) { const float v = c[i]; sc[i] = v / (1.f + __expf(-v)); }
    __syncthreads();
    for (int it = F.vcu; it < 8 * 96; it += F.G) {
        const int s = it / 96, cb = it % 96, l = s >> 1, sub = s & 1;
        const float* W = (sub ? a.in[18] : a.in[3]) + (size_t)l * D * 3072;
        const float* bias = (sub ? a.in[19] : a.in[4]) + l * 3072;
        const int c4 = F.lane & 7, kk = F.lane >> 3;
        f32x4 acc[4];
#pragma unroll
        for (int b = 0; b < 4; ++b) acc[b] = (f32x4){0.f, 0.f, 0.f, 0.f};
#pragma unroll 4
        for (int i = 0; i < 16; ++i) { const int k = F.wave * 128 + i * 8 + kk; const f32x4 w = *(const f32x4*)(W + (size_t)k * 3072 + cb * 32 + c4 * 4);
#pragma unroll
            for (int b = 0; b < 4; ++b) acc[b] += sc[b * D + k] * w; }
#pragma unroll
        for (int b = 0; b < 4; ++b)
#pragma unroll
            for (int q = 0; q < 4; ++q) { float v = acc[b][q]; v += __shfl_xor(v, 8); v += __shfl_xor(v, 16); v += __shfl_xor(v, 32); acc[b][q] = v; }
        if (F.lane < 8) {
#pragma unroll
            for (int b = 0; b < 4; ++b) *(LAS f32x4*)(red + (F.wave * 4 + b) * 32 + c4 * 4) = acc[b]; }
        __syncthreads();
        if (F.tid < 128) { const int b = F.tid >> 5, col = F.tid & 31; float v = bias[cb * 32 + col];
#pragma unroll
            for (int w = 0; w < 8; ++w) v += red[(w * 4 + b) * 32 + col];
            mod[(s * 4 + b) * 3072 + cb * 32 + col] = v; }
        __syncthreads();
    }
    LAS float* scr = (LAS float*)(F.lds + F.wave * 65 * 64 * 4);
    const int gw = F.vcu * NWAVES + F.wave, NGW = F.G * NWAVES;
    constexpr int I_IN = 4 * 16 * 40, I_OUT = 4 * 16 * 16, I_D13 = 2 * 2 * 16 * 44, I_D2 = 2 * 44 * 16, I_E13 = 16 * 2 * 16 * 22, I_E2 = 16 * 22 * 16;
    constexpr int NITEMS = I_IN + I_OUT + I_D13 + I_D2 + I_E13 + I_E2;
    for (int it = gw; it < NITEMS; it += NGW) {
        int r = it;
        if (r < I_IN) { const int l = r / 640, q = r % 640, kb = q / 40, nb = q % 40;
            transpose_item(a.in[5] + (size_t)l * D * DIN, DIN, D, kb * 64, nb * 64, (bf16_t*)(a.ws + WS_WIN) + (size_t)l * DIN * D, nb * 64, scr, F.lane); continue; } r -= I_IN;
        if (r < I_OUT) { const int l = r / 256, q = r % 256, kb = q / 16, nb = q % 16;
            transpose_item(a.in[16] + (size_t)l * D * D, D, D, kb * 64, nb * 64, (bf16_t*)(a.ws + WS_WOUT) + (size_t)l * D * D, nb * 64, scr, F.lane); continue; } r -= I_OUT;
        if (r < I_D13) { const int j = r / 1408, q = r % 1408, which = q / 704, q2 = q % 704, kb = q2 / 44, nb = q2 % 44, n0 = nb * 64;
            transpose_item((which ? a.in[21] : a.in[20]) + (size_t)j * D * DFF, DFF, D, kb * 64, n0, (bf16_t*)(a.ws + WS_W13D) + (size_t)j * 2 * DFF * D, (n0 / 128) * 256 + which * 128 + (n0 % 128), scr, F.lane); continue; } r -= I_D13;
        if (r < I_D2) { const int j = r / 704, q = r % 704, kb = q / 16, nb = q % 16;
            transpose_item(a.in[22] + (size_t)j * DFF * D, D, DFF, kb * 64, nb * 64, (bf16_t*)(a.ws + WS_W2D) + (size_t)j * D * DFF, nb * 64, scr, F.lane); continue; } r -= I_D2;
        if (r < I_E13) { const int je = r / 704, q = r % 704, which = q / 352, q2 = q % 352, kb = q2 / 22, nb = q2 % 22, n0 = nb * 64;
            transpose_item((which ? a.in[26] : a.in[25]) + (size_t)je * D * DFE, DFE, D, kb * 64, n0, (bf16_t*)(a.ws + WS_W13E) + (size_t)je * 2 * DFE * D, (n0 / 128) * 256 + which * 128 + (n0 % 128), scr, F.lane); continue; } r -= I_E13;
        { const int je = r / 352, q = r % 352, kb = q / 16, nb = q % 16;
            transpose_item(a.in[27] + (size_t)je * DFE * D, D, DFE, kb * 64, nb * 64, (bf16_t*)(a.ws + WS_W2E) + (size_t)je * D * DFE, nb * 64, scr, F.lane); }
    }
}

__device__ __forceinline__ void moe_offsets(const unsigned* cntw, int (&cnt)[8], int (&toff)[9]) {
    int t = 0;
#pragma unroll
    for (int e = 0; e < 8; ++e) { cnt[e] = (int)ld_agent(cntw + e * 64); toff[e] = t; t += (cnt[e] + 255) >> 8; }
    toff[8] = t;
}

__device__ __forceinline__ void phase_norm(const Args& a, Frame F, const float* xsrc, float* xdst, const float* gain, const float* modv  ,
                                           bool combine, const float* gate_prev  , const unsigned* cnt_prev, bool final_mode, bool route, const float* wr, const float* br, unsigned* cnt_cur) {
    asm volatile("" : "+v"(F.tid), "+v"(F.lane));
    bf16_t* hb = (bf16_t*)(a.ws + WS_HB);
    const float* YS = (const float*)(a.ws + WS_YS);
    int* tokinfo = (int*)(a.ws + WS_TOK);
    int* list = (int*)(a.ws + WS_LIST);
    LAS float* wrT = (LAS float*)(F.lds);
    LAS int* rowinfo = (LAS int*)(F.lds + 32768);
    LAS int* lcnt = (LAS int*)(F.lds + 32768 + 2048);
    if (route) {
        for (int i = F.tid; i < D * NE; i += NTHREADS) wrT[(i & 7) * D + (i >> 3)] = wr[i];
        if (F.tid < 16) lcnt[F.tid] = 0;
        __syncthreads();
    }
    const int r0 = (F.vcu * NWAVES + F.wave) * 8, b = r0 / SEQ;
    f32x4 gs[4], sh[4], gp[4];
#pragma unroll
    for (int j = 0; j < 4; ++j) { const int col = 4 * F.lane + 256 * j;
        gs[j] = *(const f32x4*)(gain + col);
        if (!final_mode) { gs[j] = gs[j] * (1.f + *(const f32x4*)(modv + b * 3072 + 1024 + col)); sh[j] = *(const f32x4*)(modv + b * 3072 + col); } else sh[j] = (f32x4){0.f, 0.f, 0.f, 0.f};
        gp[j] = combine ? *(const f32x4*)(gate_prev + b * 3072 + col) : (f32x4){0.f, 0.f, 0.f, 0.f}; }
    int pc[8], ptoff[9];
    if (combine) moe_offsets(cnt_prev, pc, ptoff);
    for (int i = 0; i < 8; ++i) {
        const int row = r0 + i;
        f32x4 v[4];
#pragma unroll
        for (int j = 0; j < 4; ++j) v[j] = *(const f32x4*)(xsrc + (size_t)row * D + 4 * F.lane + 256 * j);
        if (combine) {
            const i32x4 t0 = *(const i32x4*)(tokinfo + (size_t)row * 8), t1 = *(const i32x4*)(tokinfo + (size_t)row * 8 + 4);
            const int e1 = t0[0], p1 = t0[1], e2 = t1[0], p2 = t1[1]; const float w1 = __int_as_float(t0[2]), w2 = __int_as_float(t1[2]);
            int o1 = 0, o2 = 0;
#pragma unroll
            for (int e = 0; e < 8; ++e) { o1 = (e1 == e) ? ptoff[e] : o1; o2 = (e2 == e) ? ptoff[e] : o2; }
            const float* y1 = YS + (size_t)(o1 * 256 + p1) * D + 4 * F.lane; const float* y2 = YS + (size_t)(o2 * 256 + p2) * D + 4 * F.lane;
#pragma unroll
            for (int j = 0; j < 4; ++j) { const f32x4 a1 = *(const f32x4*)(y1 + 256 * j), a2 = *(const f32x4*)(y2 + 256 * j); v[j] = v[j] + gp[j] * (w1 * a1 + w2 * a2); }
            if (!final_mode) {
#pragma unroll
                for (int j = 0; j < 4; ++j) *(f32x4*)(xdst + (size_t)row * D + 4 * F.lane + 256 * j) = v[j]; }
        }
        float ss = 0.f;
#pragma unroll
        for (int j = 0; j < 4; ++j) ss += (v[j][0] * v[j][0] + v[j][1] * v[j][1]) + (v[j][2] * v[j][2] + v[j][3] * v[j][3]);
        ss = wave_sum(ss);
        const float rstd = rsqrtf(ss * (1.f / D) + EPS);
#pragma unroll
        for (int j = 0; j < 4; ++j) v[j] = v[j] * rstd * gs[j] + sh[j];
        if (final_mode) {
#pragma unroll
            for (int j = 0; j < 4; ++j) *(f32x4*)(xdst + (size_t)row * D + 4 * F.lane + 256 * j) = v[j];
        } else {
#pragma unroll
            for (int j = 0; j < 4; ++j) { u32x2 w; w.x = cvt_pk_bf16(v[j][0], v[j][1]); w.y = cvt_pk_bf16(v[j][2], v[j][3]); *(u32x2*)(hb + (size_t)row * D + 4 * F.lane + 256 * j) = w; }
        }
        if (route) {
            float lg[8];
#pragma unroll
            for (int e = 0; e < 8; ++e) { float s = 0.f;
#pragma unroll
                for (int j = 0; j < 4; ++j) { const f32x4 w = *(const LAS f32x4*)(wrT + e * D + 256 * j + 4 * F.lane); s += (v[j][0] * w[0] + v[j][1] * w[1]) + (v[j][2] * w[2] + v[j][3] * w[3]); }
                lg[e] = wave_sum(s) + br[e]; }
            int i1 = 0; float v1 = lg[0];
#pragma unroll
            for (int e = 1; e < 8; ++e) if (lg[e] > v1) { v1 = lg[e]; i1 = e; }
            int i2 = -1; float v2 = -3.0e38f;
#pragma unroll
            for (int e = 0; e < 8; ++e) if (e != i1 && lg[e] > v2) { v2 = lg[e]; i2 = e; }
            const float e2 = __expf(v2 - v1), w1 = 1.f / (1.f + e2), w2 = e2 / (1.f + e2);
            if (F.lane == 0) {
                const int p1 = __hip_atomic_fetch_add(lcnt + i1, 1, __ATOMIC_RELAXED, __HIP_MEMORY_SCOPE_WORKGROUP);
                const int p2 = __hip_atomic_fetch_add(lcnt + i2, 1, __ATOMIC_RELAXED, __HIP_MEMORY_SCOPE_WORKGROUP);
                LAS int* ri = rowinfo + (F.wave * 8 + i) * 8;
                ri[0] = i1; ri[1] = p1; ri[2] = __float_as_int(w1); ri[3] = 0; ri[4] = i2; ri[5] = p2; ri[6] = __float_as_int(w2); ri[7] = 0;
            }
        }
    }
    if (route) {
        __syncthreads();
        if (F.tid < 8) lcnt[8 + F.tid] = (int)__hip_atomic_fetch_add(cnt_cur + F.tid * 64, (unsigned)lcnt[F.tid], RLX_AGENT);
        __syncthreads();
        if (F.tid < 64) {
            const int row = F.vcu * 64 + F.tid; LAS int* ri = rowinfo + F.tid * 8;
            const int e1 = ri[0], e2 = ri[4], p1 = ri[1] + lcnt[8 + e1], p2 = ri[5] + lcnt[8 + e2];
            i32x4 t0 = {e1, p1, ri[2], 0}, t1 = {e2, p2, ri[6], 0};
            *(i32x4*)(tokinfo + (size_t)row * 8) = t0; *(i32x4*)(tokinfo + (size_t)row * 8 + 4) = t1;
            list[e1 * M + p1] = row; list[e2 * M + p2] = row;
        }
    }
}

__device__ __forceinline__ void phase_mixa(const Args& a, Frame F, int l) {
    asm volatile("" : "+v"(F.tid), "+v"(F.lane));
    const bf16_t* u = (const bf16_t*)(a.ws + WS_U);
    float* av = (float*)(a.ws + WS_YS); float* uv = av + (size_t)M * DL;
    const float* cw = a.in[6] + l * 4 * DL; const float* cb = a.in[7] + l * DL;
    const float* wa = a.in[8] + (size_t)l * HEADS * HD * HD; const float* ba = a.in[9] + l * DL;
    const float* wi = a.in[10] + (size_t)l * HEADS * HD * HD; const float* bi = a.in[11] + l * DL;
    const float* lam = a.in[12] + l * DL;
    LAS float* xc = (LAS float*)F.lds;
    const int c = F.tid, h = c >> 6, j = c & 63;
    const float w0 = cw[c], w1 = cw[DL + c], w2 = cw[2 * DL + c], w3 = cw[3 * DL + c], bc = cb[c];
    const float sp = log1pf(__expf(-lam[c]));
    for (int blk = F.vcu; blk < M / 32; blk += F.G) {
        const int m0 = blk * 32, t0 = m0 % SEQ;
        float x0 = 0.f, x1 = 0.f, x2 = 0.f;
        if (t0 > 0) { x0 = bf2f(u[(size_t)(m0 - 3) * DIN + c]); x1 = bf2f(u[(size_t)(m0 - 2) * DIN + c]); x2 = bf2f(u[(size_t)(m0 - 1) * DIN + c]); }
        for (int r = 0; r < 32; ++r) { const float x3 = bf2f(u[(size_t)(m0 + r) * DIN + c]); xc[r * DL + c] = bc + w0 * x0 + w1 * x1 + w2 * x2 + w3 * x3; x0 = x1; x1 = x2; x2 = x3; }
        __syncthreads();
        float ra[32], ri[32];
#pragma unroll
        for (int r = 0; r < 32; ++r) { ra[r] = ba[c]; ri[r] = bi[c]; }
        for (int i = 0; i < HD; ++i) { const float wav = wa[(h * HD + i) * HD + j], wiv = wi[(h * HD + i) * HD + j];
#pragma unroll
            for (int r = 0; r < 32; ++r) { const float xv = xc[r * DL + h * HD + i]; ra[r] += xv * wav; ri[r] += xv * wiv; } }
#pragma unroll
        for (int r = 0; r < 32; ++r) {
            const float rr = sigmoidf_(ra[r]), ii = sigmoidf_(ri[r]);
            const float log_a = -8.0f * rr * sp;
            av[(size_t)(m0 + r) * DL + c] = __expf(log_a);
            uv[(size_t)(m0 + r) * DL + c] = sqrtf(-expm1f(2.0f * log_a)) * (ii * xc[r * DL + c]);
        }
        __syncthreads();
    }
}
__device__ __forceinline__ void phase_mixb(const Args& a, Frame F) {
    asm volatile("" : "+v"(F.tid), "+v"(F.lane));
    const float* av = (const float*)(a.ws + WS_YS); float* uv = (float*)(a.ws + WS_YS) + (size_t)M * DL;
    const int gw = F.vcu * NWAVES + F.wave;
    if (F.wave != 0 || F.vcu >= 32) return;
    const int idx = F.vcu * 64 + F.lane, b = idx / DL, c = idx % DL;
    (void)gw;
    float h = 0.f;
    for (int t = 0; t < SEQ; t += 8) {
        float aa[8], uu[8];
#pragma unroll
        for (int q = 0; q < 8; ++q) { const size_t o = (size_t)(b * SEQ + t + q) * DL + c; aa[q] = av[o]; uu[q] = uv[o]; }
#pragma unroll
        for (int q = 0; q < 8; ++q) { h = aa[q] * h + uu[q]; uv[(size_t)(b * SEQ + t + q) * DL + c] = h; }
    }
}
__device__ __forceinline__ void phase_mixc(const Args& a, Frame F, int l) {
    asm volatile("" : "+v"(F.tid), "+v"(F.lane));
    const bf16_t* u = (const bf16_t*)(a.ws + WS_U);
    const float* hs = (const float*)(a.ws + WS_YS) + (size_t)M * DL;
    bf16_t* y = (bf16_t*)(a.ws + WS_YB);
    const float* scw = a.in[13] + l * 3 * DS; const float* gn_lru = a.in[14] + l * DL; const float* gn_sc = a.in[15] + l * DS;
    const int gw = F.vcu * NWAVES + F.wave, NGW = F.G * NWAVES;
    for (int it = gw; it < M * 16; it += NGW) {
        const int m = it >> 4, g = it & 15, t = m % SEQ;
        float val, gain;
        if (g < 8) {
            const int c = g * HD + F.lane;
            val = geluf_(bf2f(u[(size_t)m * DIN + DL + c])) * hs[(size_t)m * DL + c]; gain = gn_lru[c];
        } else {
            const int c = (g - 8) * HD + F.lane;
            float s = 0.f;
#pragma unroll
            for (int k = 0; k < 3; ++k) { const int tt = t - 2 + k; if (tt >= 0) { const bf16_t* ur = u + (size_t)(m - 2 + k) * DIN; s += scw[k * DS + c] * (bf2f(ur[1536 + c]) * bf2f(ur[2048 + c])); } }
            val = bf2f(u[(size_t)m * DIN + 1024 + c]) * s; gain = gn_sc[c];
        }
        const float ss = wave_sum(val * val);
        const float o = val * rsqrtf(ss * (1.f / HD) + EPS) * gain;
        const unsigned ob = cvt_pk_bf16(o, o);
        y[(size_t)m * D + g * HD + F.lane] = (bf16_t)(ob & 0xffffu);
    }
}

constexpr int PH_PER_LAYER = 9, PH_FINAL = 1 + PH_PER_LAYER * DEPTH, N_PHASES = PH_FINAL + 1;
__global__ void __launch_bounds__(NTHREADS, 2) mk_fwd(Args args) {
    extern __shared__ __attribute__((aligned(16))) unsigned char lds_raw[];
    Frame F;
    F.lds = (LAS unsigned char*)lds_raw;
    F.MISC = (volatile LAS unsigned*)(F.lds + MISC_OFF);
    F.tid = threadIdx.x; F.lane = F.tid & 63; F.wave = __builtin_amdgcn_readfirstlane(F.tid >> 6);
    F.G = gridDim.x; { const int bx = blockIdx.x; F.vcu = (F.G % 8 == 0) ? (bx % 8) * (F.G / 8) + bx / 8 : bx; }
    F.ctl = (unsigned*)(args.ws + WS_CTL);
    if (F.tid < 64) ((LAS unsigned*)(F.lds + MISC_OFF))[F.tid] = 0u;
    __syncthreads();
    const int lo = args.ph_lo, hi = args.ph_hi;
    const bool multi = (hi - lo) > 1;
    XcdBarrier bar; bar.bar = F.ctl + CW_BAR; bar.x = 0; bar.st = nullptr;
    if (multi) bar = xcd_barrier_post(F.ctl + CW_BAR, F.MISC + 8);
#define IN(k) (lo <= (k) && (k) < hi)
#define SEAM(k) do { if (IN(k) && IN((k) + 1)) xcd_barrier(bar); else __syncthreads(); } while (0)
    unsigned char* ws = args.ws;
    float* xres = args.out;
    float* modall = (float*)(ws + WS_MOD);
    bf16_t* HB = (bf16_t*)(ws + WS_HB); bf16_t* YB = (bf16_t*)(ws + WS_YB); bf16_t* UB = (bf16_t*)(ws + WS_U); float* YS = (float*)(ws + WS_YS);

    if (IN(0)) { phase_prologue(args, F); } SEAM(0);

    for (int l = 0; l < DEPTH; ++l) {
        const int pb = 1 + PH_PER_LAYER * l;
        const int j = l >> 1; const bool moe = (l & 1) != 0;
        const float* mod_mix = modall + (size_t)(2 * l) * 4 * 3072; const float* mod_ffn = modall + (size_t)(2 * l + 1) * 4 * 3072;
        unsigned* cnt_cur = F.ctl + CW_CNT + j * 8 * 64;
        if (IN(pb + 0)) {
            const bool comb = (l > 0) && (((l - 1) & 1) != 0);
            const int lp = l > 0 ? l - 1 : 0;
            const float* gate_prev = modall + (size_t)(2 * lp + 1) * 4 * 3072 + 2048;
            const unsigned* cnt_prev = F.ctl + CW_CNT + (lp >> 1) * 8 * 64;
            phase_norm(args, F, l == 0 ? args.in[0] : xres, xres, args.in[2] + l * D, mod_mix, comb, gate_prev, cnt_prev, false, false, nullptr, nullptr, nullptr);
        } SEAM(pb + 0);
        if (IN(pb + 1)) {
            pg8::Gemm g{HB, (const bf16_t*)(ws + WS_WIN) + (size_t)l * DIN * D, D};
            pg8::DenseOrder S; S.init(M / 256, DIN / 256, F.G, (int)blockIdx.x); S.rowbytes = D * 2;
            pg8::EpiBf16 E{UB, DIN};
            pg8::gemm_phase(F.lds, g, S, E);
        } SEAM(pb + 1);
        if (IN(pb + 2)) { phase_mixa(args, F, l); } SEAM(pb + 2);
        if (IN(pb + 3)) { phase_mixb(args, F); } SEAM(pb + 3);
        if (IN(pb + 4)) { phase_mixc(args, F, l); } SEAM(pb + 4);
        if (IN(pb + 5)) {
            pg8::Gemm g{YB, (const bf16_t*)(ws + WS_WOUT) + (size_t)l * D * D, D};
            pg8::DenseOrder S; S.init(M / 256, D / 256, F.G, (int)blockIdx.x); S.rowbytes = D * 2;
            pg8::EpiRes E{l == 0 ? args.in[0] : xres, xres, mod_mix + 2048};
            pg8::gemm_phase(F.lds, g, S, E);
        } SEAM(pb + 5);
        if (IN(pb + 6)) {
            phase_norm(args, F, xres, xres, args.in[17] + l * D, mod_ffn, false, nullptr, nullptr, false, moe, args.in[23] + (size_t)j * D * NE, args.in[24] + j * NE, cnt_cur);
        } SEAM(pb + 6);
        if (IN(pb + 7)) {
            if (!moe) {
                pg8::Gemm g{HB, (const bf16_t*)(ws + WS_W13D) + (size_t)j * 2 * DFF * D, D};
                pg8::DenseOrder S; S.init(M / 256, 2 * DFF / 256, F.G, (int)blockIdx.x); S.rowbytes = D * 2;
                pg8::EpiSwiGLU E{UB, DFF};
                pg8::gemm_phase(F.lds, g, S, E);
            } else {
                pg8::Gemm g{HB, (const bf16_t*)(ws + WS_W13E) + (size_t)j * NE * 2 * DFE * D, D};
                pg8::MoeOrder S; moe_offsets(cnt_cur, S.cnt, S.toff); S.init(S.toff[8], 2 * DFE / 256, F.G, (int)blockIdx.x); S.rowbytes = D * 2; S.list = (const int*)(ws + WS_LIST); S.gather = true;
                pg8::EpiSwiGLU E{UB, DFE};
                pg8::gemm_phase(F.lds, g, S, E);
            }
        } SEAM(pb + 7);
        if (IN(pb + 8)) {
            if (!moe) {
                pg8::Gemm g{UB, (const bf16_t*)(ws + WS_W2D) + (size_t)j * D * DFF, DFF};
                pg8::DenseOrder S; S.init(M / 256, D / 256, F.G, (int)blockIdx.x); S.rowbytes = DFF * 2;
                pg8::EpiRes E{xres, xres, mod_ffn + 2048};
                pg8::gemm_phase(F.lds, g, S, E);
            } else {
                pg8::Gemm g{UB, (const bf16_t*)(ws + WS_W2E) + (size_t)j * NE * D * DFE, DFE};
                pg8::MoeOrder S; moe_offsets(cnt_cur, S.cnt, S.toff); S.init(S.toff[8], D / 256, F.G, (int)blockIdx.x); S.rowbytes = DFE * 2; S.list = nullptr; S.gather = false;
                pg8::EpiF32 E{YS, D};
                pg8::gemm_phase(F.lds, g, S, E);
            }
        } SEAM(pb + 8);
    }
    if (IN(PH_FINAL)) {
        const float* gate_prev = modall + (size_t)(2 * (DEPTH - 1) + 1) * 4 * 3072 + 2048;
        const unsigned* cnt_prev = F.ctl + CW_CNT + ((DEPTH - 1) >> 1) * 8 * 64;
        phase_norm(args, F, xres, xres, args.in[28], nullptr, true, gate_prev, cnt_prev, true, false, nullptr, nullptr, nullptr);
    }
#undef IN
#undef SEAM
}
}

extern "C" void kernel_launch(void* const* d_in, const int* in_sizes, int n_in, void* d_out, int out_size, void* d_ws, size_t ws_size, hipStream_t stream) {
    static int grid = 0;
    if (grid == 0) {
        if (n_in != 29 || out_size != M * D || ws_size < WS_END) { fprintf(stderr, "kernel_launch: unexpected sizes (n_in %d out %d ws %zu)\n", n_in, out_size, ws_size); grid = -1; return; }
        int dev = 0, cus = 0, per_cu = 0;
        if (hipGetDevice(&dev) != hipSuccess || hipDeviceGetAttribute(&cus, hipDeviceAttributeMultiprocessorCount, dev) != hipSuccess) { grid = -1; return; }
        if (hipFuncSetAttribute((const void*)mk_fwd, hipFuncAttributeMaxDynamicSharedMemorySize, LDS_BYTES) != hipSuccess) { fprintf(stderr, "kernel_launch: hipFuncSetAttribute failed\n"); grid = -1; return; }
        if (hipOccupancyMaxActiveBlocksPerMultiprocessor(&per_cu, (const void*)mk_fwd, NTHREADS, LDS_BYTES) != hipSuccess || per_cu < 1) { fprintf(stderr, "kernel_launch: occupancy query says %d\n", per_cu); (void)hipGetLastError(); }
        grid = cus;
    }
    if (grid < 0) return;
    (void)hipMemsetAsync((char*)d_ws + WS_CTL, 0, CTL_ZERO_BYTES, stream);
    Args a{};
    for (int i = 0; i < 29; ++i) a.in[i] = (const float*)d_in[i];
    a.out = (float*)d_out; a.ws = (unsigned char*)d_ws;
#if MK_SINGLE
    a.ph_lo = 0; a.ph_hi = N_PHASES;
    hipLaunchKernelGGL(mk_fwd, dim3(grid), dim3(NTHREADS), LDS_BYTES, stream, a);
#else
    for (int p = 0; p < N_PHASES; ++p) { a.ph_lo = p; a.ph_hi = p + 1; hipLaunchKernelGGL(mk_fwd, dim3(grid), dim3(NTHREADS), LDS_BYTES, stream, a); }
#endif
}
```

```cpp
#include <hip/hip_runtime.h>
#include <cstdio>
#include <cstdint>

#ifndef MK_SINGLE
#define MK_SINGLE 1
#endif

#define LAS __attribute__((address_space(3)))
#define GAS __attribute__((address_space(1)))
#define RLX_AGENT __ATOMIC_RELAXED, __HIP_MEMORY_SCOPE_AGENT

namespace {
typedef unsigned short bf16_t;
typedef short bf16x8 __attribute__((ext_vector_type(8)));
typedef float f32x4 __attribute__((ext_vector_type(4)));
typedef float f32x2 __attribute__((ext_vector_type(2)));
typedef unsigned u32x4 __attribute__((ext_vector_type(4)));
typedef unsigned u32x2 __attribute__((ext_vector_type(2)));
typedef int i32x4 __attribute__((ext_vector_type(4)));

constexpr int D = 1024, BATCH = 4, SEQ = 4096, DEPTH = 4, M = BATCH * SEQ;
constexpr int DL = 512, DS = 512, HEADS = 8, HD = 64, DIN = 2560, DFF = 2816, NE = 8, DFE = 1408;
constexpr float EPS = 1e-6f;
constexpr int NWAVES = 8, NTHREADS = 512;
constexpr int MOE_ROWS = 34816;

constexpr size_t MiB = 1u << 20;
constexpr size_t WS_CTL = 0, CTL_ZERO_BYTES = 1 * MiB;
constexpr size_t WS_MOD = 1 * MiB;
constexpr size_t WS_TOK = 2 * MiB;
constexpr size_t WS_LIST = 3 * MiB;
constexpr size_t WS_WIN = 8 * MiB;
constexpr size_t WS_WOUT = 28 * MiB;
constexpr size_t WS_W13D = 36 * MiB;
constexpr size_t WS_W2D = 58 * MiB;
constexpr size_t WS_W13E = 69 * MiB;
constexpr size_t WS_W2E = 157 * MiB;
constexpr size_t WS_HB = 201 * MiB;
constexpr size_t WS_YB = 233 * MiB;
constexpr size_t WS_U = 265 * MiB;
constexpr size_t WS_YS = 359 * MiB;
constexpr size_t WS_END = 495 * MiB;
static_assert(WS_WIN + (size_t)4 * DIN * D * 2 <= WS_WOUT && WS_WOUT + (size_t)4 * D * D * 2 <= WS_W13D && WS_W13D + (size_t)2 * 2 * DFF * D * 2 <= WS_W2D &&
              WS_W2D + (size_t)2 * D * DFF * 2 <= WS_W13E && WS_W13E + (size_t)16 * 2 * DFE * D * 2 <= WS_W2E && WS_W2E + (size_t)16 * D * DFE * 2 <= WS_HB &&
              WS_U + (size_t)MOE_ROWS * DFE * 2 <= WS_YS && WS_U + (size_t)M * DFF * 2 <= WS_YS && WS_YS + (size_t)MOE_ROWS * D * 4 <= WS_END, "ws map");
constexpr int CW_TMO = 0;
constexpr int CW_BAR = 4096;
constexpr int CW_CNT = 8192;

constexpr int RING_BYTES = 131072;
constexpr int LDS_BYTES = 147456;
constexpr int MISC_OFF = LDS_BYTES - 256;

struct Args { const float* in[29]; float* out; unsigned char* ws; int ph_lo, ph_hi; };
#define CAS __attribute__((address_space(4)))
typedef const CAS Args* ArgsP;
__device__ __forceinline__ ArgsP args_ptr() { ArgsP p = (ArgsP)__builtin_amdgcn_kernarg_segment_ptr(); asm volatile("" : "+s"(p)); return p; }

__device__ __forceinline__ unsigned cvt_pk_bf16(float lo, float hi) { unsigned r; asm volatile("v_cvt_pk_bf16_f32 %0, %1, %2" : "=v"(r) : "v"(lo), "v"(hi)); return r; }
__device__ __forceinline__ float bf2f(unsigned short h) { return __uint_as_float((unsigned)h << 16); }
__device__ __forceinline__ float wave_sum(float v) {
#pragma unroll
    for (int o = 1; o < 64; o <<= 1) v += __shfl_xor(v, o);
    return v;
}
__device__ __forceinline__ float sigmoidf_(float x) { return 1.f / (1.f + __expf(-x)); }
__device__ __forceinline__ float silu_fast(float x) { return x * __builtin_amdgcn_rcpf(1.f + __builtin_amdgcn_exp2f(-1.4426950408889634f * x)); }
__device__ __forceinline__ float geluf_(float x) { return 0.5f * x * (1.f + tanhf(0.7978845608028654f * (x + 0.044715f * x * x * x))); }
__device__ __forceinline__ int lane_id() { unsigned z = 0u; asm volatile("" : "+s"(z)); return (int)__builtin_amdgcn_mbcnt_hi(~0u, __builtin_amdgcn_mbcnt_lo(~0u, z)); }
__device__ __forceinline__ unsigned ld_agent(const unsigned* p) { return __hip_atomic_load((unsigned*)p, RLX_AGENT); }

#define XB_TMO      128
#define XB_XCNT(j)  (256  + 64 * (j))
#define XB_XSUB(j)  (1280 + 64 * (j))
#define XB_XGEN(j)  (2304 + 64 * (j))
#define XB_TOP      3328
#define XB_TOPGEN   3392
#define XCD_BAR_WORDS 3456
#define XB_SPIN_CAP (1u << 18)
__device__ __forceinline__ unsigned xb_ld(unsigned* p)              { return __hip_atomic_load(p, __ATOMIC_RELAXED, __HIP_MEMORY_SCOPE_AGENT); }
__device__ __forceinline__ unsigned xb_add(unsigned* p, unsigned v) { return __hip_atomic_fetch_add(p, v, __ATOMIC_RELAXED, __HIP_MEMORY_SCOPE_AGENT); }
__device__ __forceinline__ unsigned xb_xcc_id() { return (unsigned)__builtin_amdgcn_s_getreg((3 << 11) | 20) & 0xFu; }
#define XB_SPIN(cond, bar) do { unsigned _sp = 0; while (cond) { __builtin_amdgcn_s_sleep(1); \
    if ((++_sp & 255u) == 0u) { if (xb_ld(&(bar)[XB_TMO])) break; if (_sp > XB_SPIN_CAP) { atomicAdd(&(bar)[XB_TMO], 1u); break; } } } } while (0)
struct XcdBarrier { unsigned* bar; unsigned x; volatile LAS unsigned* st; };
__device__ __forceinline__ XcdBarrier xcd_barrier_post(unsigned* bar, volatile LAS unsigned* st) {
    XcdBarrier b; b.bar = bar; b.x = xb_xcc_id(); b.st = st;
    if (threadIdx.x == 0) (void)xb_add(&bar[XB_XCNT(b.x)], 1u);
    return b;
}
__device__ __forceinline__ void xcd_barrier_complete(unsigned* bar, unsigned x, unsigned& nloc, unsigned& nx) {
    const unsigned G = gridDim.x * gridDim.y * gridDim.z;
    unsigned sum, cnt, mine, sp = 0u;
    for (;;) {
        sum = 0u; cnt = 0u; mine = 0u;
#pragma unroll
        for (unsigned j = 0; j < 16; ++j) { const unsigned c = xb_ld(&bar[XB_XCNT(j)]); sum += c; cnt += (c > 0u) ? 1u : 0u; mine = (j == x) ? c : mine; }
        if (sum == G) break;
        __builtin_amdgcn_s_sleep(1);
        if ((++sp & 255u) == 0u) { if (xb_ld(&bar[XB_TMO])) break; if (sp > XB_SPIN_CAP) { atomicAdd(&bar[XB_TMO], 1u); break; } }
    }
    nloc = mine > 0u ? mine : 1u; nx = cnt > 0u ? cnt : 1u;
}
__device__ __forceinline__ void xcd_barrier(const XcdBarrier& b, const int wave) {
    asm volatile("s_waitcnt vmcnt(0)" ::: "memory");
    __syncthreads();
    if (wave == 0 && lane_id() == 0) {
        unsigned* bar = b.bar;
        __builtin_amdgcn_s_waitcnt(0);
        unsigned nloc = b.st[0], nx = b.st[1];
        if (nloc == 0u) { xcd_barrier_complete(bar, b.x, nloc, nx); b.st[0] = nloc; b.st[1] = nx; }
        const unsigned old = xb_add(&bar[XB_XSUB(b.x)], 1u);
        const unsigned gen = old / nloc;
        if (old + 1u == (gen + 1u) * nloc) {
            __builtin_amdgcn_fence(__ATOMIC_RELEASE, "agent");
            asm volatile("s_waitcnt vmcnt(0)" ::: "memory");
            const unsigned og = xb_add(&bar[XB_TOP], 1u);
            const unsigned tg = og / nx;
            if (og + 1u == (tg + 1u) * nx) xb_add(&bar[XB_TOPGEN], 1u);
            else XB_SPIN(xb_ld(&bar[XB_TOPGEN]) == tg, bar);
            __builtin_amdgcn_fence(__ATOMIC_ACQUIRE, "agent");
            xb_add(&bar[XB_XGEN(b.x)], 1u);
            asm volatile("s_waitcnt vmcnt(0)" ::: "memory");
        } else {
            XB_SPIN(xb_ld(&bar[XB_XGEN(b.x)]) == gen, bar);
            __builtin_amdgcn_fence(__ATOMIC_ACQUIRE, "agent");
            asm volatile("s_waitcnt vmcnt(0)" ::: "memory");
        }
    }
    __syncthreads();
}

namespace pg8 {
constexpr int BM = 256, BK = 64, HALF = 128, HTB = HALF * BK * 2, STAGE_BYTES = 8 * HTB, NXCD = 8, WGM = 8;
__host__ __device__ __forceinline__ int lds_byte(int r, int c) { const int st = (r >> 4) * 2 + (c >> 5), rr = r & 15, cc = c & 31, ob = rr * 64 + cc * 2; return st * 1024 + (ob ^ (((ob >> 9) & 1) << 5)); }
__host__ __device__ __forceinline__ void stage_rc(int b, int& R, int& C) { const int st = b / 1024, sb = b % 1024, swz = sb ^ (((sb >> 9) & 1) << 5); R = (st >> 1) * 16 + swz / 64; C = (st & 1) * 32 + (swz % 64) / 2; }
__host__ __device__ __forceinline__ int perm32(int rho) { const int n = rho >> 4, i = rho & 15; return 8 * (i >> 2) + 4 * n + (i & 3); }
struct Unit { int pm, pn; };
struct Gemm { const bf16_t* A; const bf16_t* Bt; int K; };

struct StaticOrder {
    int nM, nN, nwg, G, c;
    __device__ void init(int nM_, int nN_, int G_, int c_) { nM = nM_; nN = nN_; nwg = nM * nN; G = G_; c = c_; }
    __device__ bool next(int i, Unit& u) const {
        const long L = (long)i * G + c; if (L >= nwg) return false;
        int wgid = (int)L; { const int q = nwg / NXCD, r = nwg % NXCD, xcd = wgid % NXCD, off = wgid / NXCD; wgid = (xcd < r ? xcd * (q + 1) : r * (q + 1) + (xcd - r) * q) + off; }
        const int nig = WGM * nN, gid = wgid / nig, fm = gid * WGM, gsz = (nM - fm) < WGM ? (nM - fm) : WGM;
        u.pm = fm + ((wgid % nig) % gsz); u.pn = (wgid % nig) / gsz; return true;
    }
};
struct DenseOrder : StaticOrder {
    unsigned rowbytes;
    __device__ __forceinline__ unsigned a_off(const Unit& u, int r) const { return (unsigned)(u.pm * BM + r) * rowbytes; }
    __device__ __forceinline__ int b_tile(const Unit& u) const { return u.pn; }
};
struct MoeOrder : StaticOrder {
    unsigned rowbytes; int toff[9]; int cnt[8]; const int* list; bool gather;
    __device__ __forceinline__ void expert_of(int pm, int& e, int& t0, int& c) const {
        e = 0; t0 = 0; c = cnt[0];
#pragma unroll
        for (int j = 1; j < 8; ++j) if (pm >= toff[j]) { e = j; t0 = toff[j]; c = cnt[j]; }
    }
    __device__ __forceinline__ unsigned a_off(const Unit& u, int r) const {
        if (!gather) return (unsigned)(u.pm * BM + r) * rowbytes;
        int e, t0, c; expert_of(u.pm, e, t0, c);
        int p = (u.pm - t0) * BM + r; p = p < c ? p : c - 1;
        const int tok = list[e * M + p];
        return (unsigned)tok * rowbytes;
    }
    __device__ __forceinline__ int b_tile(const Unit& u) const { int e, t0, c; expert_of(u.pm, e, t0, c); return e * nN + u.pn; }
};

struct EpiBf16 {
    static constexpr bool PERM = true;
    bf16_t* O; int ldc;
    __device__ __forceinline__ void operator()(const f32x4 (&acc)[2][2][4][2], const Unit& u, int wr, int wc, int fr, int fq) const {
        const int row0 = u.pm * BM + wr * 64 + fr, col0 = u.pn * BM + wc * 32 + 8 * fq;
#pragma unroll
        for (int ai = 0; ai < 2; ++ai)
#pragma unroll
            for (int m = 0; m < 4; ++m) { bf16_t* rowp = O + (size_t)(row0 + ai * HALF + m * 16) * ldc + col0;
#pragma unroll
                for (int bj = 0; bj < 2; ++bj) { const f32x4 v0 = acc[ai][bj][m][0], v1 = acc[ai][bj][m][1];
                    u32x4 w; w.x = cvt_pk_bf16(v0[0], v0[1]); w.y = cvt_pk_bf16(v0[2], v0[3]); w.z = cvt_pk_bf16(v1[0], v1[1]); w.w = cvt_pk_bf16(v1[2], v1[3]);
                    *(u32x4*)(rowp + bj * HALF) = w; } }
    }
};
struct EpiSwiGLU {
    static constexpr bool PERM = true;
    bf16_t* H; int ldh;
    __device__ __forceinline__ void operator()(const f32x4 (&acc)[2][2][4][2], const Unit& u, int wr, int wc, int fr, int fq) const {
        const int row0 = u.pm * BM + wr * 64 + fr, col0 = u.pn * HALF + wc * 32 + 8 * fq;
#pragma unroll
        for (int ai = 0; ai < 2; ++ai)
#pragma unroll
            for (int m = 0; m < 4; ++m) { bf16_t* rowp = H + (size_t)(row0 + ai * HALF + m * 16) * ldh + col0;
                float o[8];
#pragma unroll
                for (int n = 0; n < 2; ++n)
#pragma unroll
                    for (int q = 0; q < 4; ++q) o[n * 4 + q] = silu_fast(acc[ai][0][m][n][q]) * acc[ai][1][m][n][q];
                u32x4 w; w.x = cvt_pk_bf16(o[0], o[1]); w.y = cvt_pk_bf16(o[2], o[3]); w.z = cvt_pk_bf16(o[4], o[5]); w.w = cvt_pk_bf16(o[6], o[7]);
                *(u32x4*)rowp = w; }
    }
};
struct EpiRes {
    static constexpr bool PERM = false;
    const float* xsrc; float* xdst; const float* gate;
    __device__ __forceinline__ void operator()(const f32x4 (&acc)[2][2][4][2], const Unit& u, int wr, int wc, int fr, int fq) const {
        const int row0 = u.pm * BM + wr * 64 + fr, col0 = u.pn * BM + wc * 32 + 4 * fq, b = (u.pm * BM) / SEQ;
        f32x4 gv[2][2];
#pragma unroll
        for (int bj = 0; bj < 2; ++bj)
#pragma unroll
            for (int n = 0; n < 2; ++n) gv[bj][n] = *(const f32x4*)(gate + b * 3072 + col0 + bj * HALF + n * 16);
#pragma unroll
        for (int ai = 0; ai < 2; ++ai)
#pragma unroll
            for (int m = 0; m < 4; ++m) { const size_t off = (size_t)(row0 + ai * HALF + m * 16) * D + col0;
#pragma unroll
                for (int bj = 0; bj < 2; ++bj)
#pragma unroll
                    for (int n = 0; n < 2; ++n) { const f32x4 xs = *(const f32x4*)(xsrc + off + bj * HALF + n * 16); *(f32x4*)(xdst + off + bj * HALF + n * 16) = xs + gv[bj][n] * acc[ai][bj][m][n]; }
                if (m & 1) asm volatile("" ::: "memory"); }
    }
};
struct EpiF32 {
    static constexpr bool PERM = false;
    float* C; int ldc;
    __device__ __forceinline__ void operator()(const f32x4 (&acc)[2][2][4][2], const Unit& u, int wr, int wc, int fr, int fq) const {
        const int row0 = u.pm * BM + wr * 64 + fr, col0 = u.pn * BM + wc * 32 + 4 * fq;
#pragma unroll
        for (int ai = 0; ai < 2; ++ai)
#pragma unroll
            for (int m = 0; m < 4; ++m) { float* rowp = C + (size_t)(row0 + ai * HALF + m * 16) * ldc + col0;
#pragma unroll
                for (int bj = 0; bj < 2; ++bj)
#pragma unroll
                    for (int n = 0; n < 2; ++n) *(f32x4*)(rowp + bj * HALF + n * 16) = acc[ai][bj][m][n]; }
    }
};

template <class Epi, class Sched>
__device__ __forceinline__ void gemm_phase(LAS unsigned char* lds, const int wid, const Gemm g, const Sched& S, const Epi& E) {
    const int lane = lane_id(), tid = wid * 64 + lane,
              wr = wid >> 2, wc = wid & 3, fr = lane & 15, fq = lane >> 4;
    const int K = g.K, nt = K / BK;
    unsigned voffB[2];
#pragma unroll
    for (int i = 0; i < 2; ++i) { int R, C; stage_rc(tid * 16 + i * 8192, R, C); const int Rb = Epi::PERM ? ((R & ~31) + perm32(R & 31)) : R; voffB[i] = (unsigned)(Rb * K + C) * 2u; }
    const size_t kstep = (size_t)(BK * 2);
    const size_t hstep = (size_t)HALF * K * 2;
    const size_t tstep = 2 * hstep;
    const unsigned ldsw = (unsigned)wid * 1024u;
    const int aoff = lds_byte(wr * 64 + fr, fq * 8), boff = lds_byte(wc * 32 + fr, fq * 8);
#define PG8_SA(b, h) (((b) * 2 + (h)) * HTB)
#define PG8_SB(b, h) ((4 + (b) * 2 + (h)) * HTB)
#define PG8_STAGE(bufoff, gbase, voff) do { _Pragma("unroll") for (int _i = 0; _i < 2; ++_i) \
        __builtin_amdgcn_global_load_lds((const unsigned*)((const char*)(gbase) + (voff)[_i]), (LAS unsigned*)(lds + (bufoff) + ldsw + _i * 8192), 16, 0, 0); } while (0)
#define PG8_LDA(dst, b, h) do { _Pragma("unroll") for (int m = 0; m < 4; ++m) _Pragma("unroll") for (int k = 0; k < 2; ++k) dst[m][k] = *(const LAS bf16x8*)(lds + PG8_SA(b, h) + aoff + m * 2048 + k * 1024); } while (0)
#define PG8_LDB(dst, b, h) do { _Pragma("unroll") for (int n = 0; n < 2; ++n) _Pragma("unroll") for (int k = 0; k < 2; ++k) dst[n][k] = *(const LAS bf16x8*)(lds + PG8_SB(b, h) + boff + n * 2048 + k * 1024); } while (0)
#define PG8_MMA(ai, bj, At, Bt) do { __builtin_amdgcn_s_setprio(1); _Pragma("unroll") for (int m = 0; m < 4; ++m) _Pragma("unroll") for (int n = 0; n < 2; ++n) _Pragma("unroll") for (int k = 0; k < 2; ++k) \
        acc[ai][bj][m][n] = __builtin_amdgcn_mfma_f32_16x16x32_bf16(Bt[n][k], At[m][k], acc[ai][bj][m][n], 0, 0, 0); __builtin_amdgcn_s_setprio(0); } while (0)
#define PG8_WAIT_V(n) asm volatile("s_waitcnt vmcnt(" #n ")" ::: "memory")
#define PG8_WAIT_L(n) asm volatile("s_waitcnt lgkmcnt(" #n ")" ::: "memory")
#define PG8_BAR __builtin_amdgcn_s_barrier()
#define PG8_SCHED __builtin_amdgcn_sched_barrier(0)
    Unit cur, nxt; int ui = 0;
    if (!S.next(0, cur)) return;
    f32x4 acc[2][2][4][2];
#pragma unroll
    for (int a = 0; a < 2; ++a)
#pragma unroll
        for (int b = 0; b < 2; ++b)
#pragma unroll
            for (int m = 0; m < 4; ++m)
#pragma unroll
                for (int n = 0; n < 2; ++n) acc[a][b][m][n] = (f32x4){0.f, 0.f, 0.f, 0.f};
    bf16x8 At[4][2], B0[2][2], B1[2][2];
    unsigned oc0[2], oc1[2];
#pragma unroll
    for (int i = 0; i < 2; ++i) { int R, C; stage_rc(tid * 16 + i * 8192, R, C); oc0[i] = S.a_off(cur, R) + (unsigned)C * 2u; oc1[i] = S.a_off(cur, HALF + R) + (unsigned)C * 2u; }
    const char* Ab = (const char*)g.A;
    const char* cB = (const char*)g.Bt + (size_t)S.b_tile(cur) * tstep;
    PG8_STAGE(PG8_SB(0, 0), cB, voffB); PG8_STAGE(PG8_SB(0, 1), cB + hstep, voffB); PG8_STAGE(PG8_SA(0, 0), Ab, oc0); PG8_STAGE(PG8_SA(0, 1), Ab, oc1);
    if (wr == 1) PG8_BAR;
    PG8_WAIT_V(2); PG8_BAR;
    PG8_STAGE(PG8_SB(1, 0), cB + kstep, voffB); PG8_STAGE(PG8_SA(1, 0), Ab + kstep, oc0); PG8_STAGE(PG8_SB(1, 1), cB + hstep + kstep, voffB);
    PG8_WAIT_V(6); PG8_BAR;
    for (;;) {
        const bool has_next = S.next(ui + 1, nxt);
        const char* nB = has_next ? (const char*)g.Bt + (size_t)S.b_tile(nxt) * tstep : cB;
        for (int t = 0; t < nt; t += 2) {
            const bool last = (t == nt - 2);
            const char* a1 = Ab + (size_t)(t + 1) * kstep;
            const char* a2 = last ? Ab : Ab + (size_t)(t + 2) * kstep; const char* b2 = last ? nB : cB + (size_t)(t + 2) * kstep;
            const char* a3 = a2 + kstep; const char* b3 = b2 + kstep;
            PG8_LDB(B0, 0, 0); PG8_LDB(B1, 0, 1); PG8_SCHED; PG8_LDA(At, 0, 0); PG8_STAGE(PG8_SA(1, 1), a1, oc1);
            if (last && has_next) {
#pragma unroll
                for (int i = 0; i < 2; ++i) { int R, C; stage_rc(tid * 16 + i * 8192, R, C); oc0[i] = S.a_off(nxt, R) + (unsigned)C * 2u; oc1[i] = S.a_off(nxt, HALF + R) + (unsigned)C * 2u; }
            }
            PG8_WAIT_V(8); PG8_WAIT_L(0); PG8_BAR; PG8_MMA(0, 0, At, B0); PG8_MMA(0, 1, At, B1); PG8_BAR; PG8_SCHED;
            PG8_LDA(At, 0, 1); PG8_STAGE(PG8_SB(0, 0), b2, voffB); PG8_STAGE(PG8_SB(0, 1), b2 + hstep, voffB); PG8_STAGE(PG8_SA(0, 0), a2, oc0);
            PG8_WAIT_V(8); PG8_WAIT_L(0); PG8_BAR; PG8_MMA(1, 0, At, B0); PG8_MMA(1, 1, At, B1); PG8_BAR; PG8_SCHED;
            PG8_LDB(B0, 1, 0); PG8_LDB(B1, 1, 1); PG8_SCHED; PG8_LDA(At, 1, 0); PG8_STAGE(PG8_SA(0, 1), a2, oc1);
            PG8_WAIT_V(8); PG8_WAIT_L(0); PG8_BAR; PG8_MMA(0, 0, At, B0); PG8_MMA(0, 1, At, B1); PG8_BAR; PG8_SCHED;
            PG8_LDA(At, 1, 1); PG8_STAGE(PG8_SB(1, 0), b3, voffB); PG8_STAGE(PG8_SB(1, 1), b3 + hstep, voffB); PG8_STAGE(PG8_SA(1, 0), a3, oc0);
            PG8_WAIT_V(8); PG8_WAIT_L(0); PG8_BAR; PG8_MMA(1, 0, At, B0); PG8_MMA(1, 1, At, B1); PG8_BAR; PG8_SCHED;
        }
        if (wr == 0) PG8_BAR;
        E(acc, cur, wr, wc, fr, fq);
        if (!has_next) break;
#pragma unroll
        for (int a = 0; a < 2; ++a)
#pragma unroll
            for (int b = 0; b < 2; ++b)
#pragma unroll
                for (int m = 0; m < 4; ++m)
#pragma unroll
                    for (int n = 0; n < 2; ++n) acc[a][b][m][n] = (f32x4){0.f, 0.f, 0.f, 0.f};
        cur = nxt; cB = nB; ++ui;
        if (wr == 1) PG8_BAR;
    }
    PG8_WAIT_V(0);
    PG8_BAR;
#undef PG8_SA
#undef PG8_SB
#undef PG8_STAGE
#undef PG8_LDA
#undef PG8_LDB
#undef PG8_MMA
#undef PG8_WAIT_V
#undef PG8_WAIT_L
#undef PG8_BAR
#undef PG8_SCHED
}
}

struct Frame {
    LAS unsigned char* lds; volatile LAS unsigned* MISC; unsigned* ctl;
    int wave, vcu, G;
};

__device__ __forceinline__ void transpose_item(const float* __restrict__ W, int ldw, int K, int k0, int n0, bf16_t* WT, int drow0, LAS float* scr, int lane) {
#pragma unroll 8
    for (int kk = 0; kk < 64; ++kk) scr[kk * 65 + lane] = W[(size_t)(k0 + kk) * ldw + n0 + lane];
    asm volatile("s_waitcnt lgkmcnt(0)" ::: "memory");
    const int c = lane & 7;
#pragma unroll
    for (int j = 0; j < 8; ++j) { const int n = (lane >> 3) + 8 * j; const LAS float* s = scr + (8 * c) * 65 + n;
        u32x4 o; o.x = cvt_pk_bf16(s[0 * 65], s[1 * 65]); o.y = cvt_pk_bf16(s[2 * 65], s[3 * 65]); o.z = cvt_pk_bf16(s[4 * 65], s[5 * 65]); o.w = cvt_pk_bf16(s[6 * 65], s[7 * 65]);
        *(u32x4*)(WT + (size_t)(drow0 + n) * K + k0 + 8 * c) = o; }
    asm volatile("s_waitcnt lgkmcnt(0)" ::: "memory");
}
__device__ __forceinline__ void phase_prologue(Frame& F0) {
    ArgsP a = args_ptr();
    struct { LAS unsigned char* lds; int wave, vcu, G, lane, tid; } F; F.lds = F0.lds; F.wave = F0.wave; F.vcu = F0.vcu; F.G = F0.G; F.lane = lane_id(); F.tid = F.wave * 64 + F.lane;
    const float* c = a->in[1];
    float* mod = (float*)(a->ws + WS_MOD);
    LAS float* sc = (LAS float*)(F.lds);
    LAS float* red = (LAS float*)(F.lds + 16384);
    for (int i = F.tid; i < 4 * D; i += NTHREADS) { const float v = c[i]; sc[i] = v / (1.f + __expf(-v)); }
    __syncthreads();
    for (int it = F.vcu; it < 8 * 96; it += F.G) {
        const int s = it / 96, cb = it % 96, l = s >> 1, sub = s & 1;
        const float* W = (sub ? a->in[18] : a->in[3]) + (size_t)l * D * 3072;
        const float* bias = (sub ? a->in[19] : a->in[4]) + l * 3072;
        const int c4 = F.lane & 7, kk = F.lane >> 3;
        f32x4 acc[4];
#pragma unroll
        for (int b = 0; b < 4; ++b) acc[b] = (f32x4){0.f, 0.f, 0.f, 0.f};
#pragma unroll 4
        for (int i = 0; i < 16; ++i) { const int k = F.wave * 128 + i * 8 + kk; const f32x4 w = *(const f32x4*)(W + (size_t)k * 3072 + cb * 32 + c4 * 4);
#pragma unroll
            for (int b = 0; b < 4; ++b) acc[b] += sc[b * D + k] * w; }
#pragma unroll
        for (int b = 0; b < 4; ++b)
#pragma unroll
            for (int q = 0; q < 4; ++q) { float v = acc[b][q]; v += __shfl_xor(v, 8); v += __shfl_xor(v, 16); v += __shfl_xor(v, 32); acc[b][q] = v; }
        if (F.lane < 8) {
#pragma unroll
            for (int b = 0; b < 4; ++b) *(LAS f32x4*)(red + (F.wave * 4 + b) * 32 + c4 * 4) = acc[b]; }
        __syncthreads();
        if (F.tid < 128) { const int b = F.tid >> 5, col = F.tid & 31; float v = bias[cb * 32 + col];
#pragma unroll
            for (int w = 0; w < 8; ++w) v += red[(w * 4 + b) * 32 + col];
            mod[(s * 4 + b) * 3072 + cb * 32 + col] = v; }
        __syncthreads();
    }
    LAS float* scr = (LAS float*)(F.lds + F.wave * 65 * 64 * 4);
    const int gw = F.vcu * NWAVES + F.wave, NGW = F.G * NWAVES;
    constexpr int I_IN = 4 * 16 * 40, I_OUT = 4 * 16 * 16, I_D13 = 2 * 2 * 16 * 44, I_D2 = 2 * 44 * 16, I_E13 = 16 * 2 * 16 * 22, I_E2 = 16 * 22 * 16;
    constexpr int NITEMS = I_IN + I_OUT + I_D13 + I_D2 + I_E13 + I_E2;
    for (int it = gw; it < NITEMS; it += NGW) {
        int r = it;
        if (r < I_IN) { const int l = r / 640, q = r % 640, kb = q / 40, nb = q % 40;
            transpose_item(a->in[5] + (size_t)l * D * DIN, DIN, D, kb * 64, nb * 64, (bf16_t*)(a->ws + WS_WIN) + (size_t)l * DIN * D, nb * 64, scr, F.lane); continue; } r -= I_IN;
        if (r < I_OUT) { const int l = r / 256, q = r % 256, kb = q / 16, nb = q % 16;
            transpose_item(a->in[16] + (size_t)l * D * D, D, D, kb * 64, nb * 64, (bf16_t*)(a->ws + WS_WOUT) + (size_t)l * D * D, nb * 64, scr, F.lane); continue; } r -= I_OUT;
        if (r < I_D13) { const int j = r / 1408, q = r % 1408, which = q / 704, q2 = q % 704, kb = q2 / 44, nb = q2 % 44, n0 = nb * 64;
            transpose_item((which ? a->in[21] : a->in[20]) + (size_t)j * D * DFF, DFF, D, kb * 64, n0, (bf16_t*)(a->ws + WS_W13D) + (size_t)j * 2 * DFF * D, (n0 / 128) * 256 + which * 128 + (n0 % 128), scr, F.lane); continue; } r -= I_D13;
        if (r < I_D2) { const int j = r / 704, q = r % 704, kb = q / 16, nb = q % 16;
            transpose_item(a->in[22] + (size_t)j * DFF * D, D, DFF, kb * 64, nb * 64, (bf16_t*)(a->ws + WS_W2D) + (size_t)j * D * DFF, nb * 64, scr, F.lane); continue; } r -= I_D2;
        if (r < I_E13) { const int je = r / 704, q = r % 704, which = q / 352, q2 = q % 352, kb = q2 / 22, nb = q2 % 22, n0 = nb * 64;
            transpose_item((which ? a->in[26] : a->in[25]) + (size_t)je * D * DFE, DFE, D, kb * 64, n0, (bf16_t*)(a->ws + WS_W13E) + (size_t)je * 2 * DFE * D, (n0 / 128) * 256 + which * 128 + (n0 % 128), scr, F.lane); continue; } r -= I_E13;
        { const int je = r / 352, q = r % 352, kb = q / 16, nb = q % 16;
            transpose_item(a->in[27] + (size_t)je * DFE * D, D, DFE, kb * 64, nb * 64, (bf16_t*)(a->ws + WS_W2E) + (size_t)je * D * DFE, nb * 64, scr, F.lane); }
    }
}

__device__ __forceinline__ void moe_offsets(const unsigned* cntw, int (&cnt)[8], int (&toff)[9]) {
    int t = 0;
#pragma unroll
    for (int e = 0; e < 8; ++e) { cnt[e] = (int)ld_agent(cntw + e * 64); toff[e] = t; t += (cnt[e] + 255) >> 8; }
    toff[8] = t;
}

struct FrameL { LAS unsigned char* lds; int wave, vcu, G, lane, tid; };
__device__ __forceinline__ FrameL frame_local(const Frame& F0) { FrameL F; F.lds = F0.lds; F.wave = F0.wave; F.vcu = F0.vcu; F.G = F0.G; F.lane = lane_id(); F.tid = F.wave * 64 + F.lane; return F; }
__device__ __forceinline__ void phase_norm(ArgsP a, const Frame& F0, const float* xsrc, float* xdst, const float* gain, const float* modv  ,
                                           bool combine, const float* gate_prev  , const unsigned* cnt_prev, bool final_mode, bool route, const float* wr, const float* br, unsigned* cnt_cur) {
    const FrameL F = frame_local(F0);
    bf16_t* hb = (bf16_t*)(a->ws + WS_HB);
    const float* YS = (const float*)(a->ws + WS_YS);
    int* tokinfo = (int*)(a->ws + WS_TOK);
    int* list = (int*)(a->ws + WS_LIST);
    LAS float* wrT = (LAS float*)(F.lds);
    LAS int* rowinfo = (LAS int*)(F.lds + 32768);
    LAS int* lcnt = (LAS int*)(F.lds + 32768 + 2048);
    if (route) {
        for (int i = F.tid; i < D * NE; i += NTHREADS) wrT[(i & 7) * D + (i >> 3)] = wr[i];
        if (F.tid < 16) lcnt[F.tid] = 0;
        __syncthreads();
    }
    const int r0 = (F.vcu * NWAVES + F.wave) * 8, b = r0 / SEQ;
    f32x4 gs[4], sh[4], gp[4];
#pragma unroll
    for (int j = 0; j < 4; ++j) { const int col = 4 * F.lane + 256 * j;
        gs[j] = *(const f32x4*)(gain + col);
        if (!final_mode) { gs[j] = gs[j] * (1.f + *(const f32x4*)(modv + b * 3072 + 1024 + col)); sh[j] = *(const f32x4*)(modv + b * 3072 + col); } else sh[j] = (f32x4){0.f, 0.f, 0.f, 0.f};
        gp[j] = combine ? *(const f32x4*)(gate_prev + b * 3072 + col) : (f32x4){0.f, 0.f, 0.f, 0.f}; }
    int pc[8], ptoff[9];
    if (combine) moe_offsets(cnt_prev, pc, ptoff);
    for (int i = 0; i < 8; ++i) {
        const int row = r0 + i;
        f32x4 v[4];
#pragma unroll
        for (int j = 0; j < 4; ++j) v[j] = *(const f32x4*)(xsrc + (size_t)row * D + 4 * F.lane + 256 * j);
        if (combine) {
            const i32x4 t0 = *(const i32x4*)(tokinfo + (size_t)row * 8), t1 = *(const i32x4*)(tokinfo + (size_t)row * 8 + 4);
            const int e1 = t0[0], p1 = t0[1], e2 = t1[0], p2 = t1[1]; const float w1 = __int_as_float(t0[2]), w2 = __int_as_float(t1[2]);
            int o1 = 0, o2 = 0;
#pragma unroll
            for (int e = 0; e < 8; ++e) { o1 = (e1 == e) ? ptoff[e] : o1; o2 = (e2 == e) ? ptoff[e] : o2; }
            const float* y1 = YS + (size_t)(o1 * 256 + p1) * D + 4 * F.lane; const float* y2 = YS + (size_t)(o2 * 256 + p2) * D + 4 * F.lane;
#pragma unroll
            for (int j = 0; j < 4; ++j) { const f32x4 a1 = *(const f32x4*)(y1 + 256 * j), a2 = *(const f32x4*)(y2 + 256 * j); v[j] = v[j] + gp[j] * (w1 * a1 + w2 * a2); }
            if (!final_mode) {
#pragma unroll
                for (int j = 0; j < 4; ++j) *(f32x4*)(xdst + (size_t)row * D + 4 * F.lane + 256 * j) = v[j]; }
        }
        float ss = 0.f;
#pragma unroll
        for (int j = 0; j < 4; ++j) ss += (v[j][0] * v[j][0] + v[j][1] * v[j][1]) + (v[j][2] * v[j][2] + v[j][3] * v[j][3]);
        ss = wave_sum(ss);
        const float rstd = rsqrtf(ss * (1.f / D) + EPS);
#pragma unroll
        for (int j = 0; j < 4; ++j) v[j] = v[j] * rstd * gs[j] + sh[j];
        if (final_mode) {
#pragma unroll
            for (int j = 0; j < 4; ++j) *(f32x4*)(xdst + (size_t)row * D + 4 * F.lane + 256 * j) = v[j];
        } else {
#pragma unroll
            for (int j = 0; j < 4; ++j) { u32x2 w; w.x = cvt_pk_bf16(v[j][0], v[j][1]); w.y = cvt_pk_bf16(v[j][2], v[j][3]); *(u32x2*)(hb + (size_t)row * D + 4 * F.lane + 256 * j) = w; }
        }
        if (route) {
            float lg[8];
#pragma unroll
            for (int e = 0; e < 8; ++e) { float s = 0.f;
#pragma unroll
                for (int j = 0; j < 4; ++j) { const f32x4 w = *(const LAS f32x4*)(wrT + e * D + 256 * j + 4 * F.lane); s += (v[j][0] * w[0] + v[j][1] * w[1]) + (v[j][2] * w[2] + v[j][3] * w[3]); }
                lg[e] = wave_sum(s) + br[e]; }
            int i1 = 0; float v1 = lg[0];
#pragma unroll
            for (int e = 1; e < 8; ++e) if (lg[e] > v1) { v1 = lg[e]; i1 = e; }
            int i2 = -1; float v2 = -3.0e38f;
#pragma unroll
            for (int e = 0; e < 8; ++e) if (e != i1 && lg[e] > v2) { v2 = lg[e]; i2 = e; }
            const float e2 = __expf(v2 - v1), w1 = 1.f / (1.f + e2), w2 = e2 / (1.f + e2);
            if (F.lane == 0) {
                const int p1 = __hip_atomic_fetch_add(lcnt + i1, 1, __ATOMIC_RELAXED, __HIP_MEMORY_SCOPE_WORKGROUP);
                const int p2 = __hip_atomic_fetch_add(lcnt + i2, 1, __ATOMIC_RELAXED, __HIP_MEMORY_SCOPE_WORKGROUP);
                LAS int* ri = rowinfo + (F.wave * 8 + i) * 8;
                ri[0] = i1; ri[1] = p1; ri[2] = __float_as_int(w1); ri[3] = 0; ri[4] = i2; ri[5] = p2; ri[6] = __float_as_int(w2); ri[7] = 0;
            }
        }
    }
    if (route) {
        __syncthreads();
        if (F.tid < 8) lcnt[8 + F.tid] = (int)__hip_atomic_fetch_add(cnt_cur + F.tid * 64, (unsigned)lcnt[F.tid], RLX_AGENT);
        __syncthreads();
        if (F.tid < 64) {
            const int row = F.vcu * 64 + F.tid; LAS int* ri = rowinfo + F.tid * 8;
            const int e1 = ri[0], e2 = ri[4], p1 = ri[1] + lcnt[8 + e1], p2 = ri[5] + lcnt[8 + e2];
            i32x4 t0 = {e1, p1, ri[2], 0}, t1 = {e2, p2, ri[6], 0};
            *(i32x4*)(tokinfo + (size_t)row * 8) = t0; *(i32x4*)(tokinfo + (size_t)row * 8 + 4) = t1;
            list[e1 * M + p1] = row; list[e2 * M + p2] = row;
        }
    }
}

constexpr size_t WS_AGG = 4 * MiB;
constexpr int MIXL_WAVE = 16384, MIXL_WAVE_BYTES = 18432, MIXL_X = 0, MIXL_G = 5120, MIXL_XC = 5120 + 4608;
typedef float f32x16 __attribute__((ext_vector_type(16)));
__device__ __forceinline__ float sigm_fast(float x) { return __builtin_amdgcn_rcpf(1.f + __builtin_amdgcn_exp2f(-1.4426950408889634f * x)); }
__device__ __forceinline__ float bflo(unsigned u) { return __uint_as_float(u << 16); }
__device__ __forceinline__ float bfhi(unsigned u) { return __uint_as_float(u & 0xffff0000u); }

template <bool FULL>
__device__ __forceinline__ void lru_unit(ArgsP a, int lane, int l, int b, int chunk, int h, LAS unsigned char* wl, const LAS unsigned char* wfr) {
    const bf16_t* u = (const bf16_t*)(a->ws + WS_U);
    float* agg = (float*)(a->ws + WS_AGG);
    bf16_t* yb = (bf16_t*)(a->ws + WS_YB);
    LAS unsigned char* X = wl + MIXL_X; LAS unsigned char* G = wl + MIXL_G; LAS float* XC = (LAS float*)(wl + MIXL_XC);
    const int hh = lane >> 5, tl = lane & 31;
    bf16x8 Bf[2][2][4];
#pragma unroll
    for (int f = 0; f < 16; ++f) Bf[f >> 3][(f >> 2) & 1][f & 3] = *(const LAS bf16x8*)(wfr + f * 1024 + lane * 16);
    const int cc = h * HD + lane;
    const float cw0 = a->in[6][(l * 4 + 0) * DL + cc], cw1 = a->in[6][(l * 4 + 1) * DL + cc], cw2 = a->in[6][(l * 4 + 2) * DL + cc], cw3 = a->in[6][(l * 4 + 3) * DL + cc], cbias = a->in[7][l * DL + cc];
    float ba[2], bi[2], sp8[2], hst[2], Ac[2], Bc[2];
#pragma unroll
    for (int nt = 0; nt < 2; ++nt) { const int jj = h * HD + 32 * nt + tl; ba[nt] = a->in[9][l * DL + jj]; bi[nt] = a->in[11][l * DL + jj]; sp8[nt] = 8.0f * log1pf(__expf(-a->in[12][l * DL + jj])); hst[nt] = 0.f; Ac[nt] = 1.f; Bc[nt] = 0.f; }
    f32x4 gnv0 = {0.f, 0.f, 0.f, 0.f}, gnv1 = {0.f, 0.f, 0.f, 0.f};
    if (FULL) {
        gnv0 = *(const f32x4*)(a->in[14] + l * DL + h * HD + (lane & 7) * 8); gnv1 = *(const f32x4*)(a->in[14] + l * DL + h * HD + (lane & 7) * 8 + 4);
#pragma unroll
        for (int nt = 0; nt < 2; ++nt) {
            const float* ap = agg + ((size_t)(b * 32) * DL + h * HD + 32 * nt + tl) * 2;
            float hcar = 0.f;
            for (int j0 = 0; j0 < chunk; j0 += 16) {
                f32x2 ab[16];
#pragma unroll
                for (int j = 0; j < 16; ++j) { ab[j] = (f32x2){1.f, 0.f}; if (j0 + j < chunk) ab[j] = *(const f32x2*)(ap + (size_t)(j0 + j) * DL * 2); }
#pragma unroll
                for (int j = 0; j < 16; ++j) hcar = ab[j].x * hcar + ab[j].y;
            }
            hst[nt] = hcar;
        }
    }
    for (int blk = 0; blk < 4; ++blk) {
        const int t0 = chunk * 128 + blk * 32, m0 = b * SEQ + t0;
#pragma unroll
        for (int i = 0; i < 5; ++i) { const int idx = i * 64 + lane, row = idx >> 3, ch = idx & 7;
            if (row < 35) { u32x4 v = {0u, 0u, 0u, 0u}; if (t0 + row >= 3) v = *(const u32x4*)(u + (size_t)(m0 - 3 + row) * DIN + h * HD + ch * 8); *(LAS u32x4*)(X + row * 144 + ch * 16) = v; } }
        if (FULL) {
#pragma unroll
            for (int i = 0; i < 4; ++i) { const int idx = i * 64 + lane, row = idx >> 3, ch = idx & 7;
                const u32x4 v = *(const u32x4*)(u + (size_t)(m0 + row) * DIN + DL + h * HD + ch * 8); *(LAS u32x4*)(G + row * 144 + ch * 16) = v; }
        }
        asm volatile("" ::: "memory");
        {
            float x0 = bf2f(*(const LAS unsigned short*)(X + 0 * 144 + lane * 2)), x1 = bf2f(*(const LAS unsigned short*)(X + 1 * 144 + lane * 2)), x2 = bf2f(*(const LAS unsigned short*)(X + 2 * 144 + lane * 2));
#pragma unroll
            for (int t = 0; t < 32; ++t) {
                const float x3 = bf2f(*(const LAS unsigned short*)(X + (t + 3) * 144 + lane * 2));
                const float xc = cbias + cw0 * x0 + cw1 * x1 + cw2 * x2 + cw3 * x3;
                XC[t * 68 + lane] = xc;
                *(LAS unsigned short*)(X + (t + 3) * 144 + lane * 2) = (unsigned short)(cvt_pk_bf16(xc, xc) & 0xffffu);
                x0 = x1; x1 = x2; x2 = x3;
            }
        }
        asm volatile("" ::: "memory");
        bf16x8 Af[4];
#pragma unroll
        for (int ks = 0; ks < 4; ++ks) Af[ks] = *(const LAS bf16x8*)(X + (tl + 3) * 144 + (16 * ks + 8 * hh) * 2);
#pragma unroll
        for (int nt = 0; nt < 2; ++nt) {
            f32x16 pa, pi;
#pragma unroll
            for (int r = 0; r < 16; ++r) { pa[r] = 0.f; pi[r] = 0.f; }
#pragma unroll
            for (int ks = 0; ks < 4; ++ks) { pa = __builtin_amdgcn_mfma_f32_32x32x16_bf16(Af[ks], Bf[0][nt][ks], pa, 0, 0, 0); pi = __builtin_amdgcn_mfma_f32_32x32x16_bf16(Af[ks], Bf[1][nt][ks], pi, 0, 0, 0); }
            float av[16], uv[16];
#pragma unroll
            for (int r = 0; r < 16; ++r) {
                const int t = 4 * hh + (r & 3) + 8 * (r >> 2);
                const float rg = sigm_fast(pa[r] + ba[nt]), ig = sigm_fast(pi[r] + bi[nt]);
                const float la = -sp8[nt] * rg;
                const float aa = __builtin_amdgcn_exp2f(1.4426950408889634f * la);
                const float x2 = 2.0f * la;
                const float em_poly = -x2 * (1.f + x2 * (0.5f + x2 * (0.16666667f + x2 * (0.041666668f + x2 * (0.0083333338f + x2 * 0.0013888889f)))));
                const float em = (x2 > -0.3f) ? em_poly : (1.f - aa * aa);
                av[r] = aa; uv[r] = sqrtf(em) * ig * XC[t * 68 + 32 * nt + tl];
            }
            float hs[4]; float hcur = hst[nt];
#pragma unroll
            for (int rr = 0; rr < 4; ++rr) {
                const float A = (av[4 * rr] * av[4 * rr + 1]) * (av[4 * rr + 2] * av[4 * rr + 3]);
                float Bv = uv[4 * rr]; Bv = av[4 * rr + 1] * Bv + uv[4 * rr + 1]; Bv = av[4 * rr + 2] * Bv + uv[4 * rr + 2]; Bv = av[4 * rr + 3] * Bv + uv[4 * rr + 3];
                const float pA = __shfl_xor(A, 32), pB = __shfl_xor(Bv, 32);
                const float A1 = hh ? pA : A, B1 = hh ? pB : Bv, A2 = hh ? A : pA, B2 = hh ? Bv : pB;
                const float h1 = A1 * hcur + B1, h2 = A2 * h1 + B2;
                hs[rr] = hh ? h1 : hcur; hcur = h2;
                if (!FULL) { Bc[nt] = A1 * Bc[nt] + B1; Ac[nt] = A1 * Ac[nt]; Bc[nt] = A2 * Bc[nt] + B2; Ac[nt] = A2 * Ac[nt]; }
            }
            hst[nt] = hcur;
            if (FULL) {
#pragma unroll
                for (int rr = 0; rr < 4; ++rr) { float hv = hs[rr];
#pragma unroll
                    for (int q = 0; q < 4; ++q) { const int r = 4 * rr + q, t = 4 * hh + q + 8 * rr;
                        hv = av[r] * hv + uv[r];
                        const float gx = bf2f(*(const LAS unsigned short*)(G + t * 144 + (32 * nt + tl) * 2));
                        const float gl = gx * sigm_fast(1.5957691216057308f * (gx + 0.044715f * gx * gx * gx));
                        XC[t * 68 + 32 * nt + tl] = gl * hv; } }
            }
        }
        asm volatile("" ::: "memory");
        if (FULL) {
            const int r8 = lane >> 3, c8 = lane & 7;
#pragma unroll
            for (int p = 0; p < 4; ++p) {
                const int row = 8 * p + r8;
                const f32x4 v0 = *(const LAS f32x4*)(XC + row * 68 + c8 * 8), v1 = *(const LAS f32x4*)(XC + row * 68 + c8 * 8 + 4);
                float ss = (v0[0] * v0[0] + v0[1] * v0[1]) + (v0[2] * v0[2] + v0[3] * v0[3]) + (v1[0] * v1[0] + v1[1] * v1[1]) + (v1[2] * v1[2] + v1[3] * v1[3]);
                ss += __shfl_xor(ss, 1); ss += __shfl_xor(ss, 2); ss += __shfl_xor(ss, 4);
                const float rs = rsqrtf(ss * (1.f / HD) + EPS);
                const f32x4 o0 = v0 * rs * gnv0, o1 = v1 * rs * gnv1;
                u32x4 w; w.x = cvt_pk_bf16(o0[0], o0[1]); w.y = cvt_pk_bf16(o0[2], o0[3]); w.z = cvt_pk_bf16(o1[0], o1[1]); w.w = cvt_pk_bf16(o1[2], o1[3]);
                *(u32x4*)(yb + (size_t)(m0 + row) * D + h * HD + c8 * 8) = w;
            }
        }
        asm volatile("" ::: "memory");
    }
    if (!FULL) {
        if (hh == 0) {
#pragma unroll
            for (int nt = 0; nt < 2; ++nt) { f32x2 ab = {Ac[nt], Bc[nt]}; *(f32x2*)(agg + ((size_t)(b * 32 + chunk) * DL + h * HD + 32 * nt + tl) * 2) = ab; }
        }
    }
}

__device__ __forceinline__ void sc_unit(ArgsP a, int lane, int l, int b, int chunk, int g) {
    const bf16_t* u = (const bf16_t*)(a->ws + WS_U);
    bf16_t* yb = (bf16_t*)(a->ws + WS_YB);
    const int r4 = lane >> 3, c8 = lane & 7, c0 = g * HD + c8 * 8;
    float w0[8], w1[8], w2[8], gn[8];
#pragma unroll
    for (int q = 0; q < 8; ++q) { w0[q] = a->in[13][(l * 3 + 0) * DS + c0 + q]; w1[q] = a->in[13][(l * 3 + 1) * DS + c0 + q]; w2[q] = a->in[13][(l * 3 + 2) * DS + c0 + q]; gn[q] = a->in[15][l * DS + c0 + q]; }
    for (int step = 0; step < 4; ++step) {
        const int tb = chunk * 128 + step * 32 + r4 * 4, m = b * SEQ + tb;
        float p[6][8];
#pragma unroll
        for (int i = 0; i < 6; ++i) {
            u32x4 cv = {0u, 0u, 0u, 0u}, xv = {0u, 0u, 0u, 0u};
            if (tb - 2 + i >= 0) { cv = *(const u32x4*)(u + (size_t)(m - 2 + i) * DIN + 1536 + c0); xv = *(const u32x4*)(u + (size_t)(m - 2 + i) * DIN + 2048 + c0); }
#pragma unroll
            for (int q = 0; q < 4; ++q) { p[i][2 * q] = bflo(cv[q]) * bflo(xv[q]); p[i][2 * q + 1] = bfhi(cv[q]) * bfhi(xv[q]); }
        }
#pragma unroll
        for (int r = 0; r < 4; ++r) {
            const u32x4 bv = *(const u32x4*)(u + (size_t)(m + r) * DIN + 1024 + c0);
            float y[8]; float ss = 0.f;
#pragma unroll
            for (int q = 0; q < 8; ++q) { const float bq = (q & 1) ? bfhi(bv[q >> 1]) : bflo(bv[q >> 1]); y[q] = bq * (w0[q] * p[r][q] + w1[q] * p[r + 1][q] + w2[q] * p[r + 2][q]); ss += y[q] * y[q]; }
            ss += __shfl_xor(ss, 1); ss += __shfl_xor(ss, 2); ss += __shfl_xor(ss, 4);
            const float rs = rsqrtf(ss * (1.f / HD) + EPS);
            u32x4 w; w.x = cvt_pk_bf16(y[0] * rs * gn[0], y[1] * rs * gn[1]); w.y = cvt_pk_bf16(y[2] * rs * gn[2], y[3] * rs * gn[3]); w.z = cvt_pk_bf16(y[4] * rs * gn[4], y[5] * rs * gn[5]); w.w = cvt_pk_bf16(y[6] * rs * gn[6], y[7] * rs * gn[7]);
            *(u32x4*)(yb + (size_t)(m + r) * D + DL + c0) = w;
        }
    }
}

template <bool FULL>
__device__ __forceinline__ void phase_mix(const Frame& F0, int l) {
    ArgsP a = args_ptr();
    const FrameL F = frame_local(F0);
    const int h = F.vcu & 7, q = F.vcu >> 3;
    const float* wa = a->in[8] + (size_t)(l * HEADS + h) * HD * HD; const float* wi = a->in[10] + (size_t)(l * HEADS + h) * HD * HD;
    for (int idx = F.tid; idx < 16 * 64; idx += NTHREADS) {
        const int f = idx >> 6, ln = idx & 63, gate = f >> 3, nt = (f >> 2) & 1, ks = f & 3, kb = 16 * ks + 8 * (ln >> 5), col = 32 * nt + (ln & 31);
        const float* W = gate ? wi : wa;
        u32x4 o; o.x = cvt_pk_bf16(W[(kb + 0) * HD + col], W[(kb + 1) * HD + col]); o.y = cvt_pk_bf16(W[(kb + 2) * HD + col], W[(kb + 3) * HD + col]);
        o.z = cvt_pk_bf16(W[(kb + 4) * HD + col], W[(kb + 5) * HD + col]); o.w = cvt_pk_bf16(W[(kb + 6) * HD + col], W[(kb + 7) * HD + col]);
        *(LAS u32x4*)(F.lds + f * 1024 + ln * 16) = o;
    }
    __syncthreads();
    if (F.wave < 4) {
        const int pr = q * 4 + F.wave, b = pr >> 5, chunk = pr & 31;
        lru_unit<FULL>(a, F.lane, l, b, chunk, h, F.lds + MIXL_WAVE + F.wave * MIXL_WAVE_BYTES, F.lds);
    } else if (FULL) {
        const int pr = q * 4 + (F.wave - 4), b = pr >> 5, chunk = pr & 31;
        sc_unit(a, F.lane, l, b, chunk, h);
    }
}

constexpr int PH_PER_LAYER = 8, PH_FINAL = 1 + PH_PER_LAYER * DEPTH, N_PHASES = PH_FINAL + 1;
__global__ void __launch_bounds__(NTHREADS, 2) mk_fwd(Args args) {
    extern __shared__ __attribute__((aligned(16))) unsigned char lds_raw[];
    Frame F;
    F.lds = (LAS unsigned char*)lds_raw;
    F.MISC = (volatile LAS unsigned*)(F.lds + MISC_OFF);
    F.wave = __builtin_amdgcn_readfirstlane((int)threadIdx.x >> 6);
    F.G = gridDim.x; { const int bx = blockIdx.x; F.vcu = (F.G % 8 == 0) ? (bx % 8) * (F.G / 8) + bx / 8 : bx; }
    F.ctl = (unsigned*)(args.ws + WS_CTL);
    if (threadIdx.x < 64) ((LAS unsigned*)(F.lds + MISC_OFF))[threadIdx.x] = 0u;
    __syncthreads();
    const int lo = args.ph_lo, hi = args.ph_hi;
    const bool multi = (hi - lo) > 1;
    XcdBarrier bar; bar.bar = F.ctl + CW_BAR; bar.x = 0; bar.st = nullptr;
    if (multi) bar = xcd_barrier_post(F.ctl + CW_BAR, F.MISC + 8);
#define IN(k) (lo <= (k) && (k) < hi)
#define SEAM(k) do { if (IN(k) && IN((k) + 1)) xcd_barrier(bar, F.wave); else __syncthreads(); } while (0)
    unsigned char* ws = args.ws;
    float* xres = args.out;
    float* modall = (float*)(ws + WS_MOD);
    bf16_t* HB = (bf16_t*)(ws + WS_HB); bf16_t* YB = (bf16_t*)(ws + WS_YB); bf16_t* UB = (bf16_t*)(ws + WS_U); float* YS = (float*)(ws + WS_YS);

    if (IN(0)) { phase_prologue(F); } SEAM(0);

    for (int l = 0; l < DEPTH; ++l) {
        const int pb = 1 + PH_PER_LAYER * l;
        const int j = l >> 1; const bool moe = (l & 1) != 0;
        const float* mod_mix = modall + (size_t)(2 * l) * 4 * 3072; const float* mod_ffn = modall + (size_t)(2 * l + 1) * 4 * 3072;
        unsigned* cnt_cur = F.ctl + CW_CNT + j * 8 * 64;
        if (IN(pb + 0)) {
            const bool comb = (l > 0) && (((l - 1) & 1) != 0);
            const int lp = l > 0 ? l - 1 : 0;
            const float* gate_prev = modall + (size_t)(2 * lp + 1) * 4 * 3072 + 2048;
            const unsigned* cnt_prev = F.ctl + CW_CNT + (lp >> 1) * 8 * 64;
            ArgsP ap = args_ptr();
            phase_norm(ap, F, l == 0 ? ap->in[0] : xres, xres, ap->in[2] + l * D, mod_mix, comb, gate_prev, cnt_prev, false, false, nullptr, nullptr, nullptr);
        } SEAM(pb + 0);
        if (IN(pb + 1)) {
            pg8::Gemm g{HB, (const bf16_t*)(ws + WS_WIN) + (size_t)l * DIN * D, D};
            pg8::DenseOrder S; S.init(M / 256, DIN / 256, F.G, (int)blockIdx.x); S.rowbytes = D * 2;
            pg8::EpiBf16 E{UB, DIN};
            pg8::gemm_phase(F.lds, F.wave, g, S, E);
        } SEAM(pb + 1);
        if (IN(pb + 2)) { phase_mix<false>(F, l); } SEAM(pb + 2);
        if (IN(pb + 3)) { phase_mix<true>(F, l); } SEAM(pb + 3);
        if (IN(pb + 4)) {
            pg8::Gemm g{YB, (const bf16_t*)(ws + WS_WOUT) + (size_t)l * D * D, D};
            pg8::DenseOrder S; S.init(M / 256, D / 256, F.G, (int)blockIdx.x); S.rowbytes = D * 2;
            ArgsP ap = args_ptr();
            pg8::EpiRes E{l == 0 ? ap->in[0] : xres, xres, mod_mix + 2048};
            pg8::gemm_phase(F.lds, F.wave, g, S, E);
        } SEAM(pb + 4);
        if (IN(pb + 5)) {
            ArgsP ap = args_ptr();
            phase_norm(ap, F, xres, xres, ap->in[17] + l * D, mod_ffn, false, nullptr, nullptr, false, moe, ap->in[23] + (size_t)j * D * NE, ap->in[24] + j * NE, cnt_cur);
        } SEAM(pb + 5);
        if (IN(pb + 6)) {
            if (!moe) {
                pg8::Gemm g{HB, (const bf16_t*)(ws + WS_W13D) + (size_t)j * 2 * DFF * D, D};
                pg8::DenseOrder S; S.init(M / 256, 2 * DFF / 256, F.G, (int)blockIdx.x); S.rowbytes = D * 2;
                pg8::EpiSwiGLU E{UB, DFF};
                pg8::gemm_phase(F.lds, F.wave, g, S, E);
            } else {
                pg8::Gemm g{HB, (const bf16_t*)(ws + WS_W13E) + (size_t)j * NE * 2 * DFE * D, D};
                pg8::MoeOrder S; moe_offsets(cnt_cur, S.cnt, S.toff); S.init(S.toff[8], 2 * DFE / 256, F.G, (int)blockIdx.x); S.rowbytes = D * 2; S.list = (const int*)(ws + WS_LIST); S.gather = true;
                pg8::EpiSwiGLU E{UB, DFE};
                pg8::gemm_phase(F.lds, F.wave, g, S, E);
            }
        } SEAM(pb + 6);
        if (IN(pb + 7)) {
            if (!moe) {
                pg8::Gemm g{UB, (const bf16_t*)(ws + WS_W2D) + (size_t)j * D * DFF, DFF};
                pg8::DenseOrder S; S.init(M / 256, D / 256, F.G, (int)blockIdx.x); S.rowbytes = DFF * 2;
                pg8::EpiRes E{xres, xres, mod_ffn + 2048};
                pg8::gemm_phase(F.lds, F.wave, g, S, E);
            } else {
                pg8::Gemm g{UB, (const bf16_t*)(ws + WS_W2E) + (size_t)j * NE * D * DFE, DFE};
                pg8::MoeOrder S; moe_offsets(cnt_cur, S.cnt, S.toff); S.init(S.toff[8], D / 256, F.G, (int)blockIdx.x); S.rowbytes = DFE * 2; S.list = nullptr; S.gather = false;
                pg8::EpiF32 E{YS, D};
                pg8::gemm_phase(F.lds, F.wave, g, S, E);
            }
        } SEAM(pb + 7);
    }
    if (IN(PH_FINAL)) {
        const float* gate_prev = modall + (size_t)(2 * (DEPTH - 1) + 1) * 4 * 3072 + 2048;
        const unsigned* cnt_prev = F.ctl + CW_CNT + ((DEPTH - 1) >> 1) * 8 * 64;
        ArgsP ap = args_ptr();
        phase_norm(ap, F, xres, xres, ap->in[28], nullptr, true, gate_prev, cnt_prev, true, false, nullptr, nullptr, nullptr);
    }
#undef IN
#undef SEAM
}
}

extern "C" void kernel_launch(void* const* d_in, const int* in_sizes, int n_in, void* d_out, int out_size, void* d_ws, size_t ws_size, hipStream_t stream) {
    static int grid = 0;
    if (grid == 0) {
        if (n_in != 29 || out_size != M * D || ws_size < WS_END) { fprintf(stderr, "kernel_launch: unexpected sizes (n_in %d out %d ws %zu)\n", n_in, out_size, ws_size); grid = -1; return; }
        int dev = 0, cus = 0, per_cu = 0;
        if (hipGetDevice(&dev) != hipSuccess || hipDeviceGetAttribute(&cus, hipDeviceAttributeMultiprocessorCount, dev) != hipSuccess) { grid = -1; return; }
        if (hipFuncSetAttribute((const void*)mk_fwd, hipFuncAttributeMaxDynamicSharedMemorySize, LDS_BYTES) != hipSuccess) { fprintf(stderr, "kernel_launch: hipFuncSetAttribute failed\n"); grid = -1; return; }
        if (hipOccupancyMaxActiveBlocksPerMultiprocessor(&per_cu, (const void*)mk_fwd, NTHREADS, LDS_BYTES) != hipSuccess || per_cu < 1) { fprintf(stderr, "kernel_launch: occupancy query says %d\n", per_cu); (void)hipGetLastError(); }
        grid = cus;
    }
    if (grid < 0) return;
    (void)hipMemsetAsync((char*)d_ws + WS_CTL, 0, CTL_ZERO_BYTES, stream);
    Args a{};
    for (int i = 0; i < 29; ++i) a.in[i] = (const float*)d_in[i];
    a.out = (float*)d_out; a.ws = (unsigned char*)d_ws;
#if MK_SINGLE
    a.ph_lo = 0; a.ph_hi = N_PHASES;
    hipLaunchKernelGGL(mk_fwd, dim3(grid), dim3(NTHREADS), LDS_BYTES, stream, a);
#else
    for (int p = 0; p < N_PHASES; ++p) { a.ph_lo = p; a.ph_hi = p + 1; hipLaunchKernelGGL(mk_fwd, dim3(grid), dim3(NTHREADS), LDS_BYTES, stream, a); }
#endif
}
```

```cpp
#include <hip/hip_runtime.h>
#include <cstdio>
#include <cstdint>

#ifndef MK_SINGLE
#define MK_SINGLE 1
#endif

#ifndef REP_PRO
#define REP_PRO 1
#endif
#ifndef REP_MIX1
#define REP_MIX1 1
#endif
#ifndef REP_MIX2
#define REP_MIX2 1
#endif
#ifndef REP_NORM0
#define REP_NORM0 1
#endif
#ifndef REP_BAR
#define REP_BAR 1
#endif
#define LAS __attribute__((address_space(3)))
#define GAS __attribute__((address_space(1)))
#define RLX_AGENT __ATOMIC_RELAXED, __HIP_MEMORY_SCOPE_AGENT

namespace {
typedef unsigned short bf16_t;
typedef short bf16x8 __attribute__((ext_vector_type(8)));
typedef float f32x4 __attribute__((ext_vector_type(4)));
typedef float f32x2 __attribute__((ext_vector_type(2)));
typedef unsigned u32x4 __attribute__((ext_vector_type(4)));
typedef unsigned u32x2 __attribute__((ext_vector_type(2)));
typedef int i32x4 __attribute__((ext_vector_type(4)));

constexpr int D = 1024, BATCH = 4, SEQ = 4096, DEPTH = 4, M = BATCH * SEQ;
constexpr int DL = 512, DS = 512, HEADS = 8, HD = 64, DIN = 2560, DFF = 2816, NE = 8, DFE = 1408;
constexpr float EPS = 1e-6f;
constexpr int NWAVES = 8, NTHREADS = 512;
constexpr int MOE_ROWS = 34816;

constexpr size_t MiB = 1u << 20;
constexpr size_t WS_CTL = 0, CTL_ZERO_BYTES = 1 * MiB;
constexpr size_t WS_MOD = 1 * MiB;
constexpr size_t WS_TOK = 2 * MiB;
constexpr size_t WS_LIST = 3 * MiB;
constexpr size_t WS_AGG = 4 * MiB;
constexpr size_t WS_WFRAG = 5 * MiB;
constexpr size_t WS_WIN = 8 * MiB;
constexpr size_t WS_WOUT = 28 * MiB;
constexpr size_t WS_W13D = 36 * MiB;
constexpr size_t WS_W2D = 58 * MiB;
constexpr size_t WS_W13E = 69 * MiB;
constexpr size_t WS_W2E = 157 * MiB;
constexpr size_t WS_HB = 201 * MiB;
constexpr size_t WS_YB = 233 * MiB;
constexpr size_t WS_U = 265 * MiB;
constexpr size_t WS_YS = 359 * MiB;
constexpr size_t WS_END = 495 * MiB;
static_assert(WS_WIN + (size_t)4 * DIN * D * 2 <= WS_WOUT && WS_WOUT + (size_t)4 * D * D * 2 <= WS_W13D && WS_W13D + (size_t)2 * 2 * DFF * D * 2 <= WS_W2D &&
              WS_W2D + (size_t)2 * D * DFF * 2 <= WS_W13E && WS_W13E + (size_t)16 * 2 * DFE * D * 2 <= WS_W2E && WS_W2E + (size_t)16 * D * DFE * 2 <= WS_HB &&
              WS_U + (size_t)MOE_ROWS * DFE * 2 <= WS_YS && WS_U + (size_t)M * DFF * 2 <= WS_YS && WS_YS + (size_t)MOE_ROWS * D * 4 <= WS_END, "ws map");
constexpr int CW_TMO = 0;
constexpr int CW_BAR = 4096;
constexpr int CW_CNT = 8192;

constexpr int RING_BYTES = 131072;
constexpr int LDS_BYTES = 147456;
constexpr int MISC_OFF = LDS_BYTES - 256;

struct Args { const float* in[29]; float* out; unsigned char* ws; int ph_lo, ph_hi; };
#define CAS __attribute__((address_space(4)))
typedef const CAS Args* ArgsP;
__device__ __forceinline__ ArgsP args_ptr() { ArgsP p = (ArgsP)__builtin_amdgcn_kernarg_segment_ptr(); asm volatile("" : "+s"(p)); return p; }

__device__ __forceinline__ unsigned cvt_pk_bf16(float lo, float hi) { unsigned r; asm volatile("v_cvt_pk_bf16_f32 %0, %1, %2" : "=v"(r) : "v"(lo), "v"(hi)); return r; }
__device__ __forceinline__ float bf2f(unsigned short h) { return __uint_as_float((unsigned)h << 16); }
__device__ __forceinline__ float bflo(unsigned u) { return __uint_as_float(u << 16); }
__device__ __forceinline__ float bfhi(unsigned u) { return __uint_as_float(u & 0xffff0000u); }
__device__ __forceinline__ float wave_sum(float v) {
#pragma unroll
    for (int o = 1; o < 64; o <<= 1) v += __shfl_xor(v, o);
    return v;
}
__device__ __forceinline__ float sigmoidf_(float x) { return 1.f / (1.f + __expf(-x)); }
__device__ __forceinline__ float silu_fast(float x) { return x * __builtin_amdgcn_rcpf(1.f + __builtin_amdgcn_exp2f(-1.4426950408889634f * x)); }
__device__ __forceinline__ float geluf_(float x) { return 0.5f * x * (1.f + tanhf(0.7978845608028654f * (x + 0.044715f * x * x * x))); }
__device__ __forceinline__ int lane_id() { unsigned z = 0u; asm volatile("" : "+s"(z)); return (int)__builtin_amdgcn_mbcnt_hi(~0u, __builtin_amdgcn_mbcnt_lo(~0u, z)); }
__device__ __forceinline__ unsigned ld_agent(const unsigned* p) { return __hip_atomic_load((unsigned*)p, RLX_AGENT); }

#define XB_TMO      128
#define XB_XCNT(j)  (256  + 64 * (j))
#define XB_XSUB(j)  (1280 + 64 * (j))
#define XB_XGEN(j)  (2304 + 64 * (j))
#define XB_TOP      3328
#define XB_TOPGEN   3392
#define XCD_BAR_WORDS 3456
#define XB_SPIN_CAP (1u << 18)
__device__ __forceinline__ unsigned xb_ld(unsigned* p)              { return __hip_atomic_load(p, __ATOMIC_RELAXED, __HIP_MEMORY_SCOPE_AGENT); }
__device__ __forceinline__ unsigned xb_add(unsigned* p, unsigned v) { return __hip_atomic_fetch_add(p, v, __ATOMIC_RELAXED, __HIP_MEMORY_SCOPE_AGENT); }
__device__ __forceinline__ unsigned xb_xcc_id() { return (unsigned)__builtin_amdgcn_s_getreg((3 << 11) | 20) & 0xFu; }
#define XB_SPIN(cond, bar) do { unsigned _sp = 0; while (cond) { __builtin_amdgcn_s_sleep(1); \
    if ((++_sp & 255u) == 0u) { if (xb_ld(&(bar)[XB_TMO])) break; if (_sp > XB_SPIN_CAP) { atomicAdd(&(bar)[XB_TMO], 1u); break; } } } } while (0)
struct XcdBarrier { unsigned* bar; unsigned x; volatile LAS unsigned* st; };
__device__ __forceinline__ XcdBarrier xcd_barrier_post(unsigned* bar, volatile LAS unsigned* st) {
    XcdBarrier b; b.bar = bar; b.x = xb_xcc_id(); b.st = st;
    if (threadIdx.x == 0) (void)xb_add(&bar[XB_XCNT(b.x)], 1u);
    return b;
}
__device__ __forceinline__ void xcd_barrier_complete(unsigned* bar, unsigned x, unsigned& nloc, unsigned& nx) {
    const unsigned G = gridDim.x * gridDim.y * gridDim.z;
    unsigned sum, cnt, mine, sp = 0u;
    for (;;) {
        sum = 0u; cnt = 0u; mine = 0u;
#pragma unroll
        for (unsigned j = 0; j < 16; ++j) { const unsigned c = xb_ld(&bar[XB_XCNT(j)]); sum += c; cnt += (c > 0u) ? 1u : 0u; mine = (j == x) ? c : mine; }
        if (sum == G) break;
        __builtin_amdgcn_s_sleep(1);
        if ((++sp & 255u) == 0u) { if (xb_ld(&bar[XB_TMO])) break; if (sp > XB_SPIN_CAP) { atomicAdd(&bar[XB_TMO], 1u); break; } }
    }
    nloc = mine > 0u ? mine : 1u; nx = cnt > 0u ? cnt : 1u;
}
__device__ __forceinline__ void xcd_barrier(const XcdBarrier& b, const int wave) {
    asm volatile("s_waitcnt vmcnt(0)" ::: "memory");
    __syncthreads();
    if (wave == 0 && lane_id() == 0) {
        unsigned* bar = b.bar;
        __builtin_amdgcn_s_waitcnt(0);
        unsigned nloc = b.st[0], nx = b.st[1];
        if (nloc == 0u) { xcd_barrier_complete(bar, b.x, nloc, nx); b.st[0] = nloc; b.st[1] = nx; }
        const unsigned old = xb_add(&bar[XB_XSUB(b.x)], 1u);
        const unsigned gen = old / nloc;
        if (old + 1u == (gen + 1u) * nloc) {
            __builtin_amdgcn_fence(__ATOMIC_RELEASE, "agent");
            asm volatile("s_waitcnt vmcnt(0)" ::: "memory");
            const unsigned og = xb_add(&bar[XB_TOP], 1u);
            const unsigned tg = og / nx;
            if (og + 1u == (tg + 1u) * nx) xb_add(&bar[XB_TOPGEN], 1u);
            else XB_SPIN(xb_ld(&bar[XB_TOPGEN]) == tg, bar);
            __builtin_amdgcn_fence(__ATOMIC_ACQUIRE, "agent");
            xb_add(&bar[XB_XGEN(b.x)], 1u);
            asm volatile("s_waitcnt vmcnt(0)" ::: "memory");
        } else {
            XB_SPIN(xb_ld(&bar[XB_XGEN(b.x)]) == gen, bar);
            __builtin_amdgcn_fence(__ATOMIC_ACQUIRE, "agent");
            asm volatile("s_waitcnt vmcnt(0)" ::: "memory");
        }
    }
    __syncthreads();
}

namespace pg8 {
constexpr int BM = 256, BK = 64, HALF = 128, HTB = HALF * BK * 2, STAGE_BYTES = 8 * HTB, NXCD = 8, WGM = 8;
__host__ __device__ __forceinline__ int lds_byte(int r, int c) { const int st = (r >> 4) * 2 + (c >> 5), rr = r & 15, cc = c & 31, ob = rr * 64 + cc * 2; return st * 1024 + (ob ^ (((ob >> 9) & 1) << 5)); }
__host__ __device__ __forceinline__ void stage_rc(int b, int& R, int& C) { const int st = b / 1024, sb = b % 1024, swz = sb ^ (((sb >> 9) & 1) << 5); R = (st >> 1) * 16 + swz / 64; C = (st & 1) * 32 + (swz % 64) / 2; }
__host__ __device__ __forceinline__ int perm32(int rho) { const int n = rho >> 4, i = rho & 15; return 8 * (i >> 2) + 4 * n + (i & 3); }
struct Unit { int pm, pn; };
struct Gemm { const bf16_t* A; const bf16_t* Bt; int K; };

struct StaticOrder {
    int nM, nN, nwg, G, c;
    __device__ void init(int nM_, int nN_, int G_, int c_) { nM = nM_; nN = nN_; nwg = nM * nN; G = G_; c = c_; }
    __device__ bool next(int i, Unit& u) const {
        const long L = (long)i * G + c; if (L >= nwg) return false;
        int wgid = (int)L; { const int q = nwg / NXCD, r = nwg % NXCD, xcd = wgid % NXCD, off = wgid / NXCD; wgid = (xcd < r ? xcd * (q + 1) : r * (q + 1) + (xcd - r) * q) + off; }
        const int nig = WGM * nN, gid = wgid / nig, fm = gid * WGM, gsz = (nM - fm) < WGM ? (nM - fm) : WGM;
        u.pm = fm + ((wgid % nig) % gsz); u.pn = (wgid % nig) / gsz; return true;
    }
};
struct DenseOrder : StaticOrder {
    unsigned rowbytes;
    __device__ __forceinline__ unsigned a_off(const Unit& u, int r) const { return (unsigned)(u.pm * BM + r) * rowbytes; }
    __device__ __forceinline__ int b_tile(const Unit& u) const { return u.pn; }
};
struct MoeOrder : StaticOrder {
    unsigned rowbytes; int toff[9]; int cnt[8]; const int* list; bool gather;
    __device__ __forceinline__ void expert_of(int pm, int& e, int& t0, int& c) const {
        e = 0; t0 = 0; c = cnt[0];
#pragma unroll
        for (int j = 1; j < 8; ++j) if (pm >= toff[j]) { e = j; t0 = toff[j]; c = cnt[j]; }
    }
    __device__ __forceinline__ unsigned a_off(const Unit& u, int r) const {
        if (!gather) return (unsigned)(u.pm * BM + r) * rowbytes;
        int e, t0, c; expert_of(u.pm, e, t0, c);
        int p = (u.pm - t0) * BM + r; p = p < c ? p : c - 1;
        const int tok = list[e * M + p];
        return (unsigned)tok * rowbytes;
    }
    __device__ __forceinline__ int b_tile(const Unit& u) const { int e, t0, c; expert_of(u.pm, e, t0, c); return e * nN + u.pn; }
};

struct EpiBf16 {
    static constexpr bool PERM = true;
    bf16_t* O; int ldc;
    __device__ __forceinline__ void operator()(const f32x4 (&acc)[2][2][4][2], const Unit& u, int wr, int wc, int fr, int fq) const {
        const int row0 = u.pm * BM + wr * 64 + fr, col0 = u.pn * BM + wc * 32 + 8 * fq;
#pragma unroll
        for (int ai = 0; ai < 2; ++ai)
#pragma unroll
            for (int m = 0; m < 4; ++m) { bf16_t* rowp = O + (size_t)(row0 + ai * HALF + m * 16) * ldc + col0;
#pragma unroll
                for (int bj = 0; bj < 2; ++bj) { const f32x4 v0 = acc[ai][bj][m][0], v1 = acc[ai][bj][m][1];
                    u32x4 w; w.x = cvt_pk_bf16(v0[0], v0[1]); w.y = cvt_pk_bf16(v0[2], v0[3]); w.z = cvt_pk_bf16(v1[0], v1[1]); w.w = cvt_pk_bf16(v1[2], v1[3]);
                    *(u32x4*)(rowp + bj * HALF) = w; } }
    }
};
struct EpiSwiGLU {
    static constexpr bool PERM = true;
    bf16_t* H; int ldh;
    __device__ __forceinline__ void operator()(const f32x4 (&acc)[2][2][4][2], const Unit& u, int wr, int wc, int fr, int fq) const {
        const int row0 = u.pm * BM + wr * 64 + fr, col0 = u.pn * HALF + wc * 32 + 8 * fq;
#pragma unroll
        for (int ai = 0; ai < 2; ++ai)
#pragma unroll
            for (int m = 0; m < 4; ++m) { bf16_t* rowp = H + (size_t)(row0 + ai * HALF + m * 16) * ldh + col0;
                float o[8];
#pragma unroll
                for (int n = 0; n < 2; ++n)
#pragma unroll
                    for (int q = 0; q < 4; ++q) o[n * 4 + q] = silu_fast(acc[ai][0][m][n][q]) * acc[ai][1][m][n][q];
                u32x4 w; w.x = cvt_pk_bf16(o[0], o[1]); w.y = cvt_pk_bf16(o[2], o[3]); w.z = cvt_pk_bf16(o[4], o[5]); w.w = cvt_pk_bf16(o[6], o[7]);
                *(u32x4*)rowp = w; }
    }
};
struct EpiRes {
    static constexpr bool PERM = false;
    const float* xsrc; float* xdst; const float* gate;
    __device__ __forceinline__ void operator()(const f32x4 (&acc)[2][2][4][2], const Unit& u, int wr, int wc, int fr, int fq) const {
        const int row0 = u.pm * BM + wr * 64 + fr, col0 = u.pn * BM + wc * 32 + 4 * fq, b = (u.pm * BM) / SEQ;
        f32x4 gv[2][2];
#pragma unroll
        for (int bj = 0; bj < 2; ++bj)
#pragma unroll
            for (int n = 0; n < 2; ++n) gv[bj][n] = *(const f32x4*)(gate + b * 3072 + col0 + bj * HALF + n * 16);
#pragma unroll
        for (int ai = 0; ai < 2; ++ai)
#pragma unroll
            for (int m = 0; m < 4; ++m) { const size_t off = (size_t)(row0 + ai * HALF + m * 16) * D + col0;
#pragma unroll
                for (int bj = 0; bj < 2; ++bj)
#pragma unroll
                    for (int n = 0; n < 2; ++n) { const f32x4 xs = *(const f32x4*)(xsrc + off + bj * HALF + n * 16); *(f32x4*)(xdst + off + bj * HALF + n * 16) = xs + gv[bj][n] * acc[ai][bj][m][n]; }
                if (m & 1) asm volatile("" ::: "memory"); }
    }
};
struct EpiF32 {
    static constexpr bool PERM = false;
    float* C; int ldc;
    __device__ __forceinline__ void operator()(const f32x4 (&acc)[2][2][4][2], const Unit& u, int wr, int wc, int fr, int fq) const {
        const int row0 = u.pm * BM + wr * 64 + fr, col0 = u.pn * BM + wc * 32 + 4 * fq;
#pragma unroll
        for (int ai = 0; ai < 2; ++ai)
#pragma unroll
            for (int m = 0; m < 4; ++m) { float* rowp = C + (size_t)(row0 + ai * HALF + m * 16) * ldc + col0;
#pragma unroll
                for (int bj = 0; bj < 2; ++bj)
#pragma unroll
                    for (int n = 0; n < 2; ++n) *(f32x4*)(rowp + bj * HALF + n * 16) = acc[ai][bj][m][n]; }
    }
};

template <class Epi, class Sched>
__device__ __forceinline__ void gemm_phase(LAS unsigned char* lds, const int wid, const Gemm g, const Sched& S, const Epi& E) {
    const int lane = lane_id(), tid = wid * 64 + lane,
              wr = wid >> 2, wc = wid & 3, fr = lane & 15, fq = lane >> 4;
    const int K = g.K, nt = K / BK;
    unsigned voffB[2];
#pragma unroll
    for (int i = 0; i < 2; ++i) { int R, C; stage_rc(tid * 16 + i * 8192, R, C); const int Rb = Epi::PERM ? ((R & ~31) + perm32(R & 31)) : R; voffB[i] = (unsigned)(Rb * K + C) * 2u; }
    const size_t kstep = (size_t)(BK * 2);
    const size_t hstep = (size_t)HALF * K * 2;
    const size_t tstep = 2 * hstep;
    const unsigned ldsw = (unsigned)wid * 1024u;
    const int aoff = lds_byte(wr * 64 + fr, fq * 8), boff = lds_byte(wc * 32 + fr, fq * 8);
#define PG8_SA(b, h) (((b) * 2 + (h)) * HTB)
#define PG8_SB(b, h) ((4 + (b) * 2 + (h)) * HTB)
#define PG8_STAGE(bufoff, gbase, voff) do { _Pragma("unroll") for (int _i = 0; _i < 2; ++_i) \
        __builtin_amdgcn_global_load_lds((const unsigned*)((const char*)(gbase) + (voff)[_i]), (LAS unsigned*)(lds + (bufoff) + ldsw + _i * 8192), 16, 0, 0); } while (0)
#define PG8_LDA(dst, b, h) do { _Pragma("unroll") for (int m = 0; m < 4; ++m) _Pragma("unroll") for (int k = 0; k < 2; ++k) dst[m][k] = *(const LAS bf16x8*)(lds + PG8_SA(b, h) + aoff + m * 2048 + k * 1024); } while (0)
#define PG8_LDB(dst, b, h) do { _Pragma("unroll") for (int n = 0; n < 2; ++n) _Pragma("unroll") for (int k = 0; k < 2; ++k) dst[n][k] = *(const LAS bf16x8*)(lds + PG8_SB(b, h) + boff + n * 2048 + k * 1024); } while (0)
#define PG8_MMA(ai, bj, At, Bt) do { __builtin_amdgcn_s_setprio(1); _Pragma("unroll") for (int m = 0; m < 4; ++m) _Pragma("unroll") for (int n = 0; n < 2; ++n) _Pragma("unroll") for (int k = 0; k < 2; ++k) \
        acc[ai][bj][m][n] = __builtin_amdgcn_mfma_f32_16x16x32_bf16(Bt[n][k], At[m][k], acc[ai][bj][m][n], 0, 0, 0); __builtin_amdgcn_s_setprio(0); } while (0)
#define PG8_WAIT_V(n) asm volatile("s_waitcnt vmcnt(" #n ")" ::: "memory")
#define PG8_WAIT_L(n) asm volatile("s_waitcnt lgkmcnt(" #n ")" ::: "memory")
#define PG8_BAR __builtin_amdgcn_s_barrier()
#define PG8_SCHED __builtin_amdgcn_sched_barrier(0)
    Unit cur, nxt; int ui = 0;
    if (!S.next(0, cur)) return;
    f32x4 acc[2][2][4][2];
#pragma unroll
    for (int a = 0; a < 2; ++a)
#pragma unroll
        for (int b = 0; b < 2; ++b)
#pragma unroll
            for (int m = 0; m < 4; ++m)
#pragma unroll
                for (int n = 0; n < 2; ++n) acc[a][b][m][n] = (f32x4){0.f, 0.f, 0.f, 0.f};
    bf16x8 At[4][2], B0[2][2], B1[2][2];
    unsigned oc0[2], oc1[2];
#pragma unroll
    for (int i = 0; i < 2; ++i) { int R, C; stage_rc(tid * 16 + i * 8192, R, C); oc0[i] = S.a_off(cur, R) + (unsigned)C * 2u; oc1[i] = S.a_off(cur, HALF + R) + (unsigned)C * 2u; }
    const char* Ab = (const char*)g.A;
    const char* cB = (const char*)g.Bt + (size_t)S.b_tile(cur) * tstep;
    PG8_STAGE(PG8_SB(0, 0), cB, voffB); PG8_STAGE(PG8_SB(0, 1), cB + hstep, voffB); PG8_STAGE(PG8_SA(0, 0), Ab, oc0); PG8_STAGE(PG8_SA(0, 1), Ab, oc1);
    if (wr == 1) PG8_BAR;
    PG8_WAIT_V(2); PG8_BAR;
    PG8_STAGE(PG8_SB(1, 0), cB + kstep, voffB); PG8_STAGE(PG8_SA(1, 0), Ab + kstep, oc0); PG8_STAGE(PG8_SB(1, 1), cB + hstep + kstep, voffB);
    PG8_WAIT_V(6); PG8_BAR;
    for (;;) {
        const bool has_next = S.next(ui + 1, nxt);
        const char* nB = has_next ? (const char*)g.Bt + (size_t)S.b_tile(nxt) * tstep : cB;
        for (int t = 0; t < nt; t += 2) {
            const bool last = (t == nt - 2);
            const char* a1 = Ab + (size_t)(t + 1) * kstep;
            const char* a2 = last ? Ab : Ab + (size_t)(t + 2) * kstep; const char* b2 = last ? nB : cB + (size_t)(t + 2) * kstep;
            const char* a3 = a2 + kstep; const char* b3 = b2 + kstep;
            PG8_LDB(B0, 0, 0); PG8_LDB(B1, 0, 1); PG8_SCHED; PG8_LDA(At, 0, 0); PG8_STAGE(PG8_SA(1, 1), a1, oc1);
            if (last && has_next) {
#pragma unroll
                for (int i = 0; i < 2; ++i) { int R, C; stage_rc(tid * 16 + i * 8192, R, C); oc0[i] = S.a_off(nxt, R) + (unsigned)C * 2u; oc1[i] = S.a_off(nxt, HALF + R) + (unsigned)C * 2u; }
            }
            PG8_WAIT_V(8); PG8_WAIT_L(0); PG8_BAR; PG8_MMA(0, 0, At, B0); PG8_MMA(0, 1, At, B1); PG8_BAR; PG8_SCHED;
            PG8_LDA(At, 0, 1); PG8_STAGE(PG8_SB(0, 0), b2, voffB); PG8_STAGE(PG8_SB(0, 1), b2 + hstep, voffB); PG8_STAGE(PG8_SA(0, 0), a2, oc0);
            PG8_WAIT_V(8); PG8_WAIT_L(0); PG8_BAR; PG8_MMA(1, 0, At, B0); PG8_MMA(1, 1, At, B1); PG8_BAR; PG8_SCHED;
            PG8_LDB(B0, 1, 0); PG8_LDB(B1, 1, 1); PG8_SCHED; PG8_LDA(At, 1, 0); PG8_STAGE(PG8_SA(0, 1), a2, oc1);
            PG8_WAIT_V(8); PG8_WAIT_L(0); PG8_BAR; PG8_MMA(0, 0, At, B0); PG8_MMA(0, 1, At, B1); PG8_BAR; PG8_SCHED;
            PG8_LDA(At, 1, 1); PG8_STAGE(PG8_SB(1, 0), b3, voffB); PG8_STAGE(PG8_SB(1, 1), b3 + hstep, voffB); PG8_STAGE(PG8_SA(1, 0), a3, oc0);
            PG8_WAIT_V(8); PG8_WAIT_L(0); PG8_BAR; PG8_MMA(1, 0, At, B0); PG8_MMA(1, 1, At, B1); PG8_BAR; PG8_SCHED;
        }
        if (wr == 0) PG8_BAR;
        E(acc, cur, wr, wc, fr, fq);
        if (!has_next) break;
#pragma unroll
        for (int a = 0; a < 2; ++a)
#pragma unroll
            for (int b = 0; b < 2; ++b)
#pragma unroll
                for (int m = 0; m < 4; ++m)
#pragma unroll
                    for (int n = 0; n < 2; ++n) acc[a][b][m][n] = (f32x4){0.f, 0.f, 0.f, 0.f};
        cur = nxt; cB = nB; ++ui;
        if (wr == 1) PG8_BAR;
    }
    PG8_WAIT_V(0);
    PG8_BAR;
#undef PG8_SA
#undef PG8_SB
#undef PG8_STAGE
#undef PG8_LDA
#undef PG8_LDB
#undef PG8_MMA
#undef PG8_WAIT_V
#undef PG8_WAIT_L
#undef PG8_BAR
#undef PG8_SCHED
}
}

struct Frame {
    LAS unsigned char* lds; volatile LAS unsigned* MISC; unsigned* ctl;
    int wave, vcu, G;
};

__device__ __forceinline__ void transpose_item(const float* __restrict__ W, int ldw, int K, int k0, int n0, bf16_t* WT, int drow0, LAS float* scr, int lane) {
#pragma unroll 8
    for (int kk = 0; kk < 64; ++kk) scr[kk * 65 + lane] = W[(size_t)(k0 + kk) * ldw + n0 + lane];
    asm volatile("s_waitcnt lgkmcnt(0)" ::: "memory");
    const int c = lane & 7;
#pragma unroll
    for (int j = 0; j < 8; ++j) { const int n = (lane >> 3) + 8 * j; const LAS float* s = scr + (8 * c) * 65 + n;
        u32x4 o; o.x = cvt_pk_bf16(s[0 * 65], s[1 * 65]); o.y = cvt_pk_bf16(s[2 * 65], s[3 * 65]); o.z = cvt_pk_bf16(s[4 * 65], s[5 * 65]); o.w = cvt_pk_bf16(s[6 * 65], s[7 * 65]);
        *(u32x4*)(WT + (size_t)(drow0 + n) * K + k0 + 8 * c) = o; }
    asm volatile("s_waitcnt lgkmcnt(0)" ::: "memory");
}
__device__ __forceinline__ void phase_prologue(Frame& F0) {
    ArgsP a = args_ptr();
    struct { LAS unsigned char* lds; int wave, vcu, G, lane, tid; } F; F.lds = F0.lds; F.wave = F0.wave; F.vcu = F0.vcu; F.G = F0.G; F.lane = lane_id(); F.tid = F.wave * 64 + F.lane;
    const float* c = a->in[1];
    float* mod = (float*)(a->ws + WS_MOD);
    LAS float* sc = (LAS float*)(F.lds);
    LAS float* red = (LAS float*)(F.lds + 16384);
    for (int i = F.tid; i < 4 * D; i += NTHREADS) { const float v = c[i]; sc[i] = v / (1.f + __expf(-v)); }
    __syncthreads();
    for (int it = F.vcu; it < 8 * 96; it += F.G) {
        const int s = it / 96, cb = it % 96, l = s >> 1, sub = s & 1;
        const float* W = (sub ? a->in[18] : a->in[3]) + (size_t)l * D * 3072;
        const float* bias = (sub ? a->in[19] : a->in[4]) + l * 3072;
        const int c4 = F.lane & 7, kk = F.lane >> 3;
        f32x4 acc[4];
#pragma unroll
        for (int b = 0; b < 4; ++b) acc[b] = (f32x4){0.f, 0.f, 0.f, 0.f};
#pragma unroll 4
        for (int i = 0; i < 16; ++i) { const int k = F.wave * 128 + i * 8 + kk; const f32x4 w = *(const f32x4*)(W + (size_t)k * 3072 + cb * 32 + c4 * 4);
#pragma unroll
            for (int b = 0; b < 4; ++b) acc[b] += sc[b * D + k] * w; }
#pragma unroll
        for (int b = 0; b < 4; ++b)
#pragma unroll
            for (int q = 0; q < 4; ++q) { float v = acc[b][q]; v += __shfl_xor(v, 8); v += __shfl_xor(v, 16); v += __shfl_xor(v, 32); acc[b][q] = v; }
        if (F.lane < 8) {
#pragma unroll
            for (int b = 0; b < 4; ++b) *(LAS f32x4*)(red + (F.wave * 4 + b) * 32 + c4 * 4) = acc[b]; }
        __syncthreads();
        if (F.tid < 128) { const int b = F.tid >> 5, col = F.tid & 31; float v = bias[cb * 32 + col];
#pragma unroll
            for (int w = 0; w < 8; ++w) v += red[(w * 4 + b) * 32 + col];
            mod[(s * 4 + b) * 3072 + cb * 32 + col] = v; }
        __syncthreads();
    }
    for (int idx = F.vcu * NTHREADS + F.tid; idx < 4 * 8 * 16 * 64; idx += F.G * NTHREADS) {
        const int ln = idx & 63, f = (idx >> 6) & 15, lh = idx >> 10, gate = f >> 3, nt = (f >> 2) & 1, ks = f & 3, kb = 16 * ks + 8 * (ln >> 5), col = 32 * nt + (ln & 31);
        const float* W = (gate ? a->in[10] : a->in[8]) + (size_t)lh * HD * HD;
        u32x4 o; o.x = cvt_pk_bf16(W[(kb + 0) * HD + col], W[(kb + 1) * HD + col]); o.y = cvt_pk_bf16(W[(kb + 2) * HD + col], W[(kb + 3) * HD + col]);
        o.z = cvt_pk_bf16(W[(kb + 4) * HD + col], W[(kb + 5) * HD + col]); o.w = cvt_pk_bf16(W[(kb + 6) * HD + col], W[(kb + 7) * HD + col]);
        ((u32x4*)(a->ws + WS_WFRAG))[idx] = o;
    }
    LAS float* scr = (LAS float*)(F.lds + F.wave * 65 * 64 * 4);
    const int gw = F.vcu * NWAVES + F.wave, NGW = F.G * NWAVES;
    constexpr int I_IN = 4 * 16 * 40, I_OUT = 4 * 16 * 16, I_D13 = 2 * 2 * 16 * 44, I_D2 = 2 * 44 * 16, I_E13 = 16 * 2 * 16 * 22, I_E2 = 16 * 22 * 16;
    constexpr int NITEMS = I_IN + I_OUT + I_D13 + I_D2 + I_E13 + I_E2;
    for (int it = gw; it < NITEMS; it += NGW) {
        int r = it;
        if (r < I_IN) { const int l = r / 640, q = r % 640, kb = q / 40, nb = q % 40;
            transpose_item(a->in[5] + (size_t)l * D * DIN, DIN, D, kb * 64, nb * 64, (bf16_t*)(a->ws + WS_WIN) + (size_t)l * DIN * D, nb * 64, scr, F.lane); continue; } r -= I_IN;
        if (r < I_OUT) { const int l = r / 256, q = r % 256, kb = q / 16, nb = q % 16;
            transpose_item(a->in[16] + (size_t)l * D * D, D, D, kb * 64, nb * 64, (bf16_t*)(a->ws + WS_WOUT) + (size_t)l * D * D, nb * 64, scr, F.lane); continue; } r -= I_OUT;
        if (r < I_D13) { const int j = r / 1408, q = r % 1408, which = q / 704, q2 = q % 704, kb = q2 / 44, nb = q2 % 44, n0 = nb * 64;
            transpose_item((which ? a->in[21] : a->in[20]) + (size_t)j * D * DFF, DFF, D, kb * 64, n0, (bf16_t*)(a->ws + WS_W13D) + (size_t)j * 2 * DFF * D, (n0 / 128) * 256 + which * 128 + (n0 % 128), scr, F.lane); continue; } r -= I_D13;
        if (r < I_D2) { const int j = r / 704, q = r % 704, kb = q / 16, nb = q % 16;
            transpose_item(a->in[22] + (size_t)j * DFF * D, D, DFF, kb * 64, nb * 64, (bf16_t*)(a->ws + WS_W2D) + (size_t)j * D * DFF, nb * 64, scr, F.lane); continue; } r -= I_D2;
        if (r < I_E13) { const int je = r / 704, q = r % 704, which = q / 352, q2 = q % 352, kb = q2 / 22, nb = q2 % 22, n0 = nb * 64;
            transpose_item((which ? a->in[26] : a->in[25]) + (size_t)je * D * DFE, DFE, D, kb * 64, n0, (bf16_t*)(a->ws + WS_W13E) + (size_t)je * 2 * DFE * D, (n0 / 128) * 256 + which * 128 + (n0 % 128), scr, F.lane); continue; } r -= I_E13;
        { const int je = r / 352, q = r % 352, kb = q / 16, nb = q % 16;
            transpose_item(a->in[27] + (size_t)je * DFE * D, D, DFE, kb * 64, nb * 64, (bf16_t*)(a->ws + WS_W2E) + (size_t)je * D * DFE, nb * 64, scr, F.lane); }
    }
}

__device__ __forceinline__ void moe_offsets(const unsigned* cntw, int (&cnt)[8], int (&toff)[9]) {
    int t = 0;
#pragma unroll
    for (int e = 0; e < 8; ++e) { cnt[e] = (int)ld_agent(cntw + e * 64); toff[e] = t; t += (cnt[e] + 255) >> 8; }
    toff[8] = t;
}

struct FrameL { LAS unsigned char* lds; int wave, vcu, G, lane, tid; };
__device__ __forceinline__ FrameL frame_local(const Frame& F0) { FrameL F; F.lds = F0.lds; F.wave = F0.wave; F.vcu = F0.vcu; F.G = F0.G; F.lane = lane_id(); F.tid = F.wave * 64 + F.lane; return F; }
__device__ __forceinline__ void phase_norm(ArgsP a, const Frame& F0, const float* xsrc, float* xdst, const float* gain, const float* modv  ,
                                           bool combine, const float* gate_prev  , const unsigned* cnt_prev, bool final_mode, bool route, const float* wr, const float* br, unsigned* cnt_cur) {
    const FrameL F = frame_local(F0);
    bf16_t* hb = (bf16_t*)(a->ws + WS_HB);
    const bf16_t* YS = (const bf16_t*)(a->ws + WS_YS);
    int* tokinfo = (int*)(a->ws + WS_TOK);
    int* list = (int*)(a->ws + WS_LIST);
    LAS float* wrT = (LAS float*)(F.lds);
    LAS int* rowinfo = (LAS int*)(F.lds + 32768);
    LAS int* lcnt = (LAS int*)(F.lds + 32768 + 2048);
    if (route) {
        for (int i = F.tid; i < D * NE; i += NTHREADS) wrT[(i & 7) * D + (i >> 3)] = wr[i];
        if (F.tid < 16) lcnt[F.tid] = 0;
        __syncthreads();
    }
    const int r0 = (F.vcu * NWAVES + F.wave) * 8, b = r0 / SEQ;
    f32x4 gs[4], sh[4], gp[4];
#pragma unroll
    for (int j = 0; j < 4; ++j) { const int col = 4 * F.lane + 256 * j;
        gs[j] = *(const f32x4*)(gain + col);
        if (!final_mode) { gs[j] = gs[j] * (1.f + *(const f32x4*)(modv + b * 3072 + 1024 + col)); sh[j] = *(const f32x4*)(modv + b * 3072 + col); } else sh[j] = (f32x4){0.f, 0.f, 0.f, 0.f};
        gp[j] = combine ? *(const f32x4*)(gate_prev + b * 3072 + col) : (f32x4){0.f, 0.f, 0.f, 0.f}; }
    int pc[8], ptoff[9];
    if (combine) moe_offsets(cnt_prev, pc, ptoff);
    for (int i = 0; i < 8; ++i) {
        const int row = r0 + i;
        f32x4 v[4];
#pragma unroll
        for (int j = 0; j < 4; ++j) v[j] = *(const f32x4*)(xsrc + (size_t)row * D + 4 * F.lane + 256 * j);
        if (combine) {
            const i32x4 t0 = *(const i32x4*)(tokinfo + (size_t)row * 8), t1 = *(const i32x4*)(tokinfo + (size_t)row * 8 + 4);
            const int e1 = t0[0], p1 = t0[1], e2 = t1[0], p2 = t1[1]; const float w1 = __int_as_float(t0[2]), w2 = __int_as_float(t1[2]);
            int o1 = 0, o2 = 0;
#pragma unroll
            for (int e = 0; e < 8; ++e) { o1 = (e1 == e) ? ptoff[e] : o1; o2 = (e2 == e) ? ptoff[e] : o2; }
            const bf16_t* y1 = YS + (size_t)(o1 * 256 + p1) * D + 4 * F.lane; const bf16_t* y2 = YS + (size_t)(o2 * 256 + p2) * D + 4 * F.lane;
#pragma unroll
            for (int j = 0; j < 4; ++j) { const u32x2 q1 = *(const u32x2*)(y1 + 256 * j), q2 = *(const u32x2*)(y2 + 256 * j);
                const f32x4 a1 = {bflo(q1.x), bfhi(q1.x), bflo(q1.y), bfhi(q1.y)}, a2 = {bflo(q2.x), bfhi(q2.x), bflo(q2.y), bfhi(q2.y)};
                v[j] = v[j] + gp[j] * (w1 * a1 + w2 * a2); }
            if (!final_mode) {
#pragma unroll
                for (int j = 0; j < 4; ++j) *(f32x4*)(xdst + (size_t)row * D + 4 * F.lane + 256 * j) = v[j]; }
        }
        float ss = 0.f;
#pragma unroll
        for (int j = 0; j < 4; ++j) ss += (v[j][0] * v[j][0] + v[j][1] * v[j][1]) + (v[j][2] * v[j][2] + v[j][3] * v[j][3]);
        ss = wave_sum(ss);
        const float rstd = rsqrtf(ss * (1.f / D) + EPS);
#pragma unroll
        for (int j = 0; j < 4; ++j) v[j] = v[j] * rstd * gs[j] + sh[j];
        if (final_mode) {
#pragma unroll
            for (int j = 0; j < 4; ++j) *(f32x4*)(xdst + (size_t)row * D + 4 * F.lane + 256 * j) = v[j];
        } else {
#pragma unroll
            for (int j = 0; j < 4; ++j) { u32x2 w; w.x = cvt_pk_bf16(v[j][0], v[j][1]); w.y = cvt_pk_bf16(v[j][2], v[j][3]); *(u32x2*)(hb + (size_t)row * D + 4 * F.lane + 256 * j) = w; }
        }
        if (route) {
            float lg[8];
#pragma unroll
            for (int e = 0; e < 8; ++e) { float s = 0.f;
#pragma unroll
                for (int j = 0; j < 4; ++j) { const f32x4 w = *(const LAS f32x4*)(wrT + e * D + 256 * j + 4 * F.lane); s += (v[j][0] * w[0] + v[j][1] * w[1]) + (v[j][2] * w[2] + v[j][3] * w[3]); }
                lg[e] = wave_sum(s) + br[e]; }
            int i1 = 0; float v1 = lg[0];
#pragma unroll
            for (int e = 1; e < 8; ++e) if (lg[e] > v1) { v1 = lg[e]; i1 = e; }
            int i2 = -1; float v2 = -3.0e38f;
#pragma unroll
            for (int e = 0; e < 8; ++e) if (e != i1 && lg[e] > v2) { v2 = lg[e]; i2 = e; }
            const float e2 = __expf(v2 - v1), w1 = 1.f / (1.f + e2), w2 = e2 / (1.f + e2);
            if (F.lane == 0) {
                const int p1 = __hip_atomic_fetch_add(lcnt + i1, 1, __ATOMIC_RELAXED, __HIP_MEMORY_SCOPE_WORKGROUP);
                const int p2 = __hip_atomic_fetch_add(lcnt + i2, 1, __ATOMIC_RELAXED, __HIP_MEMORY_SCOPE_WORKGROUP);
                LAS int* ri = rowinfo + (F.wave * 8 + i) * 8;
                ri[0] = i1; ri[1] = p1; ri[2] = __float_as_int(w1); ri[3] = 0; ri[4] = i2; ri[5] = p2; ri[6] = __float_as_int(w2); ri[7] = 0;
            }
        }
    }
    if (route) {
        __syncthreads();
        if (F.tid < 8) lcnt[8 + F.tid] = (int)__hip_atomic_fetch_add(cnt_cur + F.tid * 64, (unsigned)lcnt[F.tid], RLX_AGENT);
        __syncthreads();
        if (F.tid < 64) {
            const int row = F.vcu * 64 + F.tid; LAS int* ri = rowinfo + F.tid * 8;
            const int e1 = ri[0], e2 = ri[4], p1 = ri[1] + lcnt[8 + e1], p2 = ri[5] + lcnt[8 + e2];
            i32x4 t0 = {e1, p1, ri[2], 0}, t1 = {e2, p2, ri[6], 0};
            *(i32x4*)(tokinfo + (size_t)row * 8) = t0; *(i32x4*)(tokinfo + (size_t)row * 8 + 4) = t1;
            list[e1 * M + p1] = row; list[e2 * M + p2] = row;
        }
    }
}


constexpr int MIXL_WAVE = 16384, MIXL_WAVE_BYTES = 18432, MIXL_X = 0, MIXL_G = 5120, MIXL_XC = 5120 + 4608;
typedef float f32x16 __attribute__((ext_vector_type(16)));
__device__ __forceinline__ float sigm_fast(float x) { return __builtin_amdgcn_rcpf(1.f + __builtin_amdgcn_exp2f(-1.4426950408889634f * x)); }

template <bool FULL>
__device__ __forceinline__ void lru_unit(ArgsP a, int lane, int l, int b, int chunk, int h, LAS unsigned char* wl, const LAS unsigned char* wfr) {
    const bf16_t* u = (const bf16_t*)(a->ws + WS_U);
    float* agg = (float*)(a->ws + WS_AGG);
    bf16_t* yb = (bf16_t*)(a->ws + WS_YB);
    LAS unsigned char* X = wl + MIXL_X; LAS unsigned char* G = wl + MIXL_G; LAS float* XC = (LAS float*)(wl + MIXL_XC);
    const int hh = lane >> 5, tl = lane & 31;
    bf16x8 Bf[2][2][4];
#pragma unroll
    for (int f = 0; f < 16; ++f) Bf[f >> 3][(f >> 2) & 1][f & 3] = *(const LAS bf16x8*)(wfr + f * 1024 + lane * 16);
    const int cc = h * HD + lane;
    const float cw0 = a->in[6][(l * 4 + 0) * DL + cc], cw1 = a->in[6][(l * 4 + 1) * DL + cc], cw2 = a->in[6][(l * 4 + 2) * DL + cc], cw3 = a->in[6][(l * 4 + 3) * DL + cc], cbias = a->in[7][l * DL + cc];
    float ba[2], bi[2], sp8[2], hst[2], Ac[2], Bc[2];
#pragma unroll
    for (int nt = 0; nt < 2; ++nt) { const int jj = h * HD + 32 * nt + tl; ba[nt] = a->in[9][l * DL + jj]; bi[nt] = a->in[11][l * DL + jj]; sp8[nt] = 8.0f * log1pf(__expf(-a->in[12][l * DL + jj])); hst[nt] = 0.f; Ac[nt] = 1.f; Bc[nt] = 0.f; }
    f32x4 gnv0 = {0.f, 0.f, 0.f, 0.f}, gnv1 = {0.f, 0.f, 0.f, 0.f};
    if (FULL) {
        gnv0 = *(const f32x4*)(a->in[14] + l * DL + h * HD + (lane & 7) * 8); gnv1 = *(const f32x4*)(a->in[14] + l * DL + h * HD + (lane & 7) * 8 + 4);
#pragma unroll
        for (int nt = 0; nt < 2; ++nt) {
            const float* ap = agg + ((size_t)(b * 32) * DL + h * HD + 32 * nt + tl) * 2;
            float hcar = 0.f;
            for (int j0 = 0; j0 < chunk; j0 += 16) {
                f32x2 ab[16];
#pragma unroll
                for (int j = 0; j < 16; ++j) { ab[j] = (f32x2){1.f, 0.f}; if (j0 + j < chunk) ab[j] = *(const f32x2*)(ap + (size_t)(j0 + j) * DL * 2); }
#pragma unroll
                for (int j = 0; j < 16; ++j) hcar = ab[j].x * hcar + ab[j].y;
            }
            hst[nt] = hcar;
        }
    }
    for (int blk = 0; blk < 4; ++blk) {
        const int t0 = chunk * 128 + blk * 32, m0 = b * SEQ + t0;
#pragma unroll
        for (int i = 0; i < 5; ++i) { const int idx = i * 64 + lane, row = idx >> 3, ch = idx & 7;
            if (row < 35) { u32x4 v = {0u, 0u, 0u, 0u}; if (t0 + row >= 3) v = *(const u32x4*)(u + (size_t)(m0 - 3 + row) * DIN + h * HD + ch * 8); *(LAS u32x4*)(X + row * 144 + ch * 16) = v; } }
        if (FULL) {
#pragma unroll
            for (int i = 0; i < 4; ++i) { const int idx = i * 64 + lane, row = idx >> 3, ch = idx & 7;
                const u32x4 v = *(const u32x4*)(u + (size_t)(m0 + row) * DIN + DL + h * HD + ch * 8); *(LAS u32x4*)(G + row * 144 + ch * 16) = v; }
        }
        asm volatile("" ::: "memory");
        {
            float x0 = bf2f(*(const LAS unsigned short*)(X + 0 * 144 + lane * 2)), x1 = bf2f(*(const LAS unsigned short*)(X + 1 * 144 + lane * 2)), x2 = bf2f(*(const LAS unsigned short*)(X + 2 * 144 + lane * 2));
#pragma unroll
            for (int t = 0; t < 32; ++t) {
                const float x3 = bf2f(*(const LAS unsigned short*)(X + (t + 3) * 144 + lane * 2));
                const float xc = cbias + cw0 * x0 + cw1 * x1 + cw2 * x2 + cw3 * x3;
                XC[t * 68 + lane] = xc;
                *(LAS unsigned short*)(X + (t + 3) * 144 + lane * 2) = (unsigned short)(cvt_pk_bf16(xc, xc) & 0xffffu);
                x0 = x1; x1 = x2; x2 = x3;
            }
        }
        asm volatile("" ::: "memory");
        bf16x8 Af[4];
#pragma unroll
        for (int ks = 0; ks < 4; ++ks) Af[ks] = *(const LAS bf16x8*)(X + (tl + 3) * 144 + (16 * ks + 8 * hh) * 2);
#pragma unroll
        for (int nt = 0; nt < 2; ++nt) {
            f32x16 pa, pi;
#pragma unroll
            for (int r = 0; r < 16; ++r) { pa[r] = 0.f; pi[r] = 0.f; }
#pragma unroll
            for (int ks = 0; ks < 4; ++ks) { pa = __builtin_amdgcn_mfma_f32_32x32x16_bf16(Af[ks], Bf[0][nt][ks], pa, 0, 0, 0); pi = __builtin_amdgcn_mfma_f32_32x32x16_bf16(Af[ks], Bf[1][nt][ks], pi, 0, 0, 0); }
            float av[16], uv[16];
#pragma unroll
            for (int r = 0; r < 16; ++r) {
                const int t = 4 * hh + (r & 3) + 8 * (r >> 2);
                const float rg = sigm_fast(pa[r] + ba[nt]), ig = sigm_fast(pi[r] + bi[nt]);
                const float la = -sp8[nt] * rg;
                const float aa = __builtin_amdgcn_exp2f(1.4426950408889634f * la);
                const float x2 = 2.0f * la;
                const float em_poly = -x2 * (1.f + x2 * (0.5f + x2 * (0.16666667f + x2 * (0.041666668f + x2 * (0.0083333338f + x2 * 0.0013888889f)))));
                const float em = (x2 > -0.3f) ? em_poly : (1.f - aa * aa);
                av[r] = aa; uv[r] = sqrtf(em) * ig * XC[t * 68 + 32 * nt + tl];
            }
            float hs[4]; float hcur = hst[nt];
#pragma unroll
            for (int rr = 0; rr < 4; ++rr) {
                const float A = (av[4 * rr] * av[4 * rr + 1]) * (av[4 * rr + 2] * av[4 * rr + 3]);
                float Bv = uv[4 * rr]; Bv = av[4 * rr + 1] * Bv + uv[4 * rr + 1]; Bv = av[4 * rr + 2] * Bv + uv[4 * rr + 2]; Bv = av[4 * rr + 3] * Bv + uv[4 * rr + 3];
                const float pA = __shfl_xor(A, 32), pB = __shfl_xor(Bv, 32);
                const float A1 = hh ? pA : A, B1 = hh ? pB : Bv, A2 = hh ? A : pA, B2 = hh ? Bv : pB;
                const float h1 = A1 * hcur + B1, h2 = A2 * h1 + B2;
                hs[rr] = hh ? h1 : hcur; hcur = h2;
                if (!FULL) { Bc[nt] = A1 * Bc[nt] + B1; Ac[nt] = A1 * Ac[nt]; Bc[nt] = A2 * Bc[nt] + B2; Ac[nt] = A2 * Ac[nt]; }
            }
            hst[nt] = hcur;
            if (FULL) {
#pragma unroll
                for (int rr = 0; rr < 4; ++rr) { float hv = hs[rr];
#pragma unroll
                    for (int q = 0; q < 4; ++q) { const int r = 4 * rr + q, t = 4 * hh + q + 8 * rr;
                        hv = av[r] * hv + uv[r];
                        const float gx = bf2f(*(const LAS unsigned short*)(G + t * 144 + (32 * nt + tl) * 2));
                        const float gl = gx * sigm_fast(1.5957691216057308f * (gx + 0.044715f * gx * gx * gx));
                        XC[t * 68 + 32 * nt + tl] = gl * hv; } }
            }
        }
        asm volatile("" ::: "memory");
        if (FULL) {
            const int r8 = lane >> 3, c8 = lane & 7;
#pragma unroll
            for (int p = 0; p < 4; ++p) {
                const int row = 8 * p + r8;
                const f32x4 v0 = *(const LAS f32x4*)(XC + row * 68 + c8 * 8), v1 = *(const LAS f32x4*)(XC + row * 68 + c8 * 8 + 4);
                float ss = (v0[0] * v0[0] + v0[1] * v0[1]) + (v0[2] * v0[2] + v0[3] * v0[3]) + (v1[0] * v1[0] + v1[1] * v1[1]) + (v1[2] * v1[2] + v1[3] * v1[3]);
                ss += __shfl_xor(ss, 1); ss += __shfl_xor(ss, 2); ss += __shfl_xor(ss, 4);
                const float rs = rsqrtf(ss * (1.f / HD) + EPS);
                const f32x4 o0 = v0 * rs * gnv0, o1 = v1 * rs * gnv1;
                u32x4 w; w.x = cvt_pk_bf16(o0[0], o0[1]); w.y = cvt_pk_bf16(o0[2], o0[3]); w.z = cvt_pk_bf16(o1[0], o1[1]); w.w = cvt_pk_bf16(o1[2], o1[3]);
                *(u32x4*)(yb + (size_t)(m0 + row) * D + h * HD + c8 * 8) = w;
            }
        }
        asm volatile("" ::: "memory");
    }
    if (!FULL) {
        if (hh == 0) {
#pragma unroll
            for (int nt = 0; nt < 2; ++nt) { f32x2 ab = {Ac[nt], Bc[nt]}; *(f32x2*)(agg + ((size_t)(b * 32 + chunk) * DL + h * HD + 32 * nt + tl) * 2) = ab; }
        }
    }
}

constexpr int CW_MIXC = 16384;
constexpr int MIX3_WAVE = 0, MIX3_WAVE_BYTES = 11776, MIX3_X = 0, MIX3_G = 5120, MIX3_BA = 9728;
constexpr int MIX3_EX = MIX3_WAVE + 8 * MIX3_WAVE_BYTES;
constexpr int MIX3_FLAG = MIX3_EX + 4096;
static_assert(MIX3_FLAG + 64 <= MISC_OFF, "mix LDS map");
__device__ __forceinline__ void sc_half(ArgsP a, int lane, int l, int b, int chunk, int g, int half);
__device__ __forceinline__ void lru_half(ArgsP a, int lane, int l, int b, int chunk, int h, int pair, int half, LAS unsigned char* lds) {
    const bf16_t* u = (const bf16_t*)(a->ws + WS_U);
    unsigned long long* agg = (unsigned long long*)(a->ws + WS_AGG);
    bf16_t* yb = (bf16_t*)(a->ws + WS_YB);
    unsigned* ctl = (unsigned*)(a->ws + WS_CTL);
    unsigned* cntw = ctl + CW_MIXC + ((l * 4 + b) * 8 + h) * 64;
    u32x4* scratch = (u32x4*)(a->ws + WS_YS) + (size_t)((((b * 32 + chunk) * 8 + h) * 2 + half)) * 1024;
    LAS unsigned char* wl = lds + MIX3_WAVE + (half * 4 + pair) * MIX3_WAVE_BYTES;
    LAS unsigned char* X = wl + MIX3_X; LAS unsigned char* G = wl + MIX3_G; LAS float* BA = (LAS float*)(wl + MIX3_BA); LAS float* XC = (LAS float*)wl;
    LAS float* EX = (LAS float*)(lds + MIX3_EX); volatile LAS unsigned* EXF = (volatile LAS unsigned*)(lds + MISC_OFF + 64);
    const unsigned epoch = (unsigned)l + 1u;
    const int hh = lane >> 5, tl = lane & 31;
    bf16x8 Bf[2][2][4];
#pragma unroll
    for (int f = 0; f < 16; ++f) Bf[f >> 3][(f >> 2) & 1][f & 3] = ((const bf16x8*)(a->ws + WS_WFRAG))[((l * HEADS + h) * 16 + f) * 64 + lane];
    const int cc = h * HD + lane;
    const float cw0 = a->in[6][(l * 4 + 0) * DL + cc], cw1 = a->in[6][(l * 4 + 1) * DL + cc], cw2 = a->in[6][(l * 4 + 2) * DL + cc], cw3 = a->in[6][(l * 4 + 3) * DL + cc], cbias = a->in[7][l * DL + cc];
    float ba[2], bi[2], sp8[2], Ac[2], Bc[2];
#pragma unroll
    for (int nt = 0; nt < 2; ++nt) { const int jj = h * HD + 32 * nt + tl; ba[nt] = a->in[9][l * DL + jj]; bi[nt] = a->in[11][l * DL + jj]; sp8[nt] = 8.0f * log1pf(__expf(-a->in[12][l * DL + jj])); Ac[nt] = 1.f; Bc[nt] = 0.f; }
    for (int blk = 0; blk < 2; ++blk) {
        const int t0 = chunk * 128 + (half * 2 + blk) * 32, m0 = b * SEQ + t0;
#pragma unroll
        for (int i = 0; i < 5; ++i) { const int idx = i * 64 + lane, row = idx >> 3, ch = idx & 7;
            if (row < 35) { u32x4 v = {0u, 0u, 0u, 0u}; if (t0 + row >= 3) v = *(const u32x4*)(u + (size_t)(m0 - 3 + row) * DIN + h * HD + ch * 8); *(LAS u32x4*)(X + row * 144 + ch * 16) = v; } }
#pragma unroll
        for (int i = 0; i < 4; ++i) { const int idx = i * 64 + lane, row = idx >> 3, ch = idx & 7;
            const u32x4 v = *(const u32x4*)(u + (size_t)(m0 + row) * DIN + DL + h * HD + ch * 8); *(LAS u32x4*)(G + row * 144 + ch * 16) = v; }
        asm volatile("" ::: "memory");
        {
            float x0 = bf2f(*(const LAS unsigned short*)(X + 0 * 144 + lane * 2)), x1 = bf2f(*(const LAS unsigned short*)(X + 1 * 144 + lane * 2)), x2 = bf2f(*(const LAS unsigned short*)(X + 2 * 144 + lane * 2));
#pragma unroll
            for (int t = 0; t < 32; ++t) {
                const float x3 = bf2f(*(const LAS unsigned short*)(X + (t + 3) * 144 + lane * 2));
                const float xc = cbias + cw0 * x0 + cw1 * x1 + cw2 * x2 + cw3 * x3;
                *(LAS unsigned short*)(X + (t + 3) * 144 + lane * 2) = (unsigned short)(cvt_pk_bf16(xc, xc) & 0xffffu);
                x0 = x1; x1 = x2; x2 = x3;
            }
        }
        asm volatile("" ::: "memory");
        bf16x8 Af[4];
#pragma unroll
        for (int ks = 0; ks < 4; ++ks) Af[ks] = *(const LAS bf16x8*)(X + (tl + 3) * 144 + (16 * ks + 8 * hh) * 2);
#pragma unroll
        for (int nt = 0; nt < 2; ++nt) {
            f32x16 pa, pi;
#pragma unroll
            for (int r = 0; r < 16; ++r) { pa[r] = 0.f; pi[r] = 0.f; }
#pragma unroll
            for (int ks = 0; ks < 4; ++ks) { pa = __builtin_amdgcn_mfma_f32_32x32x16_bf16(Af[ks], Bf[0][nt][ks], pa, 0, 0, 0); pi = __builtin_amdgcn_mfma_f32_32x32x16_bf16(Af[ks], Bf[1][nt][ks], pi, 0, 0, 0); }
            float av[16], uv[16];
#pragma unroll
            for (int r = 0; r < 16; ++r) {
                const int t = 4 * hh + (r & 3) + 8 * (r >> 2);
                const float rg = sigm_fast(pa[r] + ba[nt]), ig = sigm_fast(pi[r] + bi[nt]);
                const float la = -sp8[nt] * rg;
                const float aa = __builtin_amdgcn_exp2f(1.4426950408889634f * la);
                const float x2 = 2.0f * la;
                const float em_poly = -x2 * (1.f + x2 * (0.5f + x2 * (0.16666667f + x2 * (0.041666668f + x2 * (0.0083333338f + x2 * 0.0013888889f)))));
                const float em = (x2 > -0.3f) ? em_poly : (1.f - aa * aa);
                av[r] = aa; uv[r] = __builtin_amdgcn_sqrtf(em) * ig * bf2f(*(const LAS unsigned short*)(X + (t + 3) * 144 + (32 * nt + tl) * 2));
            }
            float hcur = 0.f, pcur = 1.f;
#pragma unroll
            for (int rr = 0; rr < 4; ++rr) {
                const float A = (av[4 * rr] * av[4 * rr + 1]) * (av[4 * rr + 2] * av[4 * rr + 3]);
                float Bv = uv[4 * rr]; Bv = av[4 * rr + 1] * Bv + uv[4 * rr + 1]; Bv = av[4 * rr + 2] * Bv + uv[4 * rr + 2]; Bv = av[4 * rr + 3] * Bv + uv[4 * rr + 3];
                const float pA = __shfl_xor(A, 32), pB = __shfl_xor(Bv, 32);
                const float A1 = hh ? pA : A, B1 = hh ? pB : Bv, A2 = hh ? A : pA, B2 = hh ? Bv : pB;
                const float h1 = A1 * hcur + B1, h2 = A2 * h1 + B2, p1 = A1 * pcur, p2 = A2 * p1;
                float hv = hh ? h1 : hcur, pv = hh ? p1 : pcur;
                hcur = h2; pcur = p2;
                unsigned pk[4];
#pragma unroll
                for (int q = 0; q < 4; ++q) { const int r = 4 * rr + q, t = 4 * hh + q + 8 * rr;
                    hv = av[r] * hv + uv[r]; pv = av[r] * pv;
                    const float gx = bf2f(*(const LAS unsigned short*)(G + t * 144 + (32 * nt + tl) * 2));
                    const float gl = gx * sigm_fast(1.5957691216057308f * (gx + 0.044715f * gx * gx * gx));
                    pk[q] = cvt_pk_bf16(gl * hv, gl * pv); }
                u32x4 w = {pk[0], pk[1], pk[2], pk[3]};
                scratch[((blk * 2 + nt) * 4 + rr) * 64 + lane] = w;
            }
            BA[((blk * 2 + nt) * 2 + 0) * 64 + lane] = pcur; BA[((blk * 2 + nt) * 2 + 1) * 64 + lane] = hcur;
            Bc[nt] = pcur * Bc[nt] + hcur; Ac[nt] = pcur * Ac[nt];
        }
        asm volatile("" ::: "memory");
    }
    if (hh == 0) {
#pragma unroll
        for (int nt = 0; nt < 2; ++nt) { EX[(((pair * 2 + half) * 2 + nt) * 2 + 0) * 32 + tl] = Ac[nt]; EX[(((pair * 2 + half) * 2 + nt) * 2 + 1) * 32 + tl] = Bc[nt]; }
    }
    asm volatile("s_waitcnt lgkmcnt(0)" ::: "memory");
    if (lane == 0) EXF[pair * 2 + half] = epoch;
    {
        unsigned spins = 0;
        while (EXF[pair * 2 + (half ^ 1)] != epoch) { __builtin_amdgcn_s_sleep(1); if (++spins > (1u << 22)) { if (lane == 0) __hip_atomic_store(ctl + CW_TMO, 0x310u, RLX_AGENT); break; } }
    }
    asm volatile("" ::: "memory");
    float oA[2], oB[2];
#pragma unroll
    for (int nt = 0; nt < 2; ++nt) { oA[nt] = EX[(((pair * 2 + (half ^ 1)) * 2 + nt) * 2 + 0) * 32 + tl]; oB[nt] = EX[(((pair * 2 + (half ^ 1)) * 2 + nt) * 2 + 1) * 32 + tl]; }
    if (half == 0) {
        if (hh == 0) {
#pragma unroll
            for (int nt = 0; nt < 2; ++nt) { const float Ap = oA[nt] * Ac[nt], Bp = oA[nt] * Bc[nt] + oB[nt];
                __hip_atomic_store(agg + ((size_t)(b * 32 + chunk) * DL + h * HD + 32 * nt + tl), ((unsigned long long)__float_as_uint(Bp) << 32) | __float_as_uint(Ap), RLX_AGENT); }
        }
        asm volatile("s_waitcnt vmcnt(0)" ::: "memory");
        if (lane == 0) __hip_atomic_fetch_add(cntw, 1u, RLX_AGENT);
    }
    sc_half(a, lane, l, b, chunk, h, half);
    {
        unsigned spins = 0;
        while ((unsigned)__builtin_amdgcn_readfirstlane((int)ld_agent(cntw)) < 32u) {
            __builtin_amdgcn_s_sleep(2);
            if (++spins > (1u << 20)) { if (lane == 0) __hip_atomic_store(ctl + CW_TMO, 0x300u, RLX_AGENT); break; }
        }
    }
    asm volatile("" ::: "memory");
    float hin[2];
    {
        unsigned long long* ap = agg + ((size_t)(b * 32) * DL + h * HD + 32 * hh + tl);
        unsigned long long ab[32];
#pragma unroll
        for (int j = 0; j < 32; ++j) { ab[j] = 0x3f800000ull; if (j < chunk) ab[j] = __hip_atomic_load(ap + (size_t)j * DL, RLX_AGENT); }
        float hcar = 0.f;
#pragma unroll
        for (int j = 0; j < 32; ++j) hcar = __uint_as_float((unsigned)ab[j]) * hcar + __uint_as_float((unsigned)(ab[j] >> 32));
        const float other = __shfl_xor(hcar, 32);
        const float c0 = hh ? other : hcar, c1 = hh ? hcar : other;
        hin[0] = half ? (oA[0] * c0 + oB[0]) : c0; hin[1] = half ? (oA[1] * c1 + oB[1]) : c1;
    }
    const f32x4 gnv0 = *(const f32x4*)(a->in[14] + l * DL + h * HD + (lane & 7) * 8), gnv1 = *(const f32x4*)(a->in[14] + l * DL + h * HD + (lane & 7) * 8 + 4);
    for (int blk = 0; blk < 2; ++blk) {
        const int m0 = b * SEQ + chunk * 128 + (half * 2 + blk) * 32;
#pragma unroll
        for (int nt = 0; nt < 2; ++nt) {
            u32x4 w[4];
#pragma unroll
            for (int rr = 0; rr < 4; ++rr) w[rr] = scratch[((blk * 2 + nt) * 4 + rr) * 64 + lane];
#pragma unroll
            for (int rr = 0; rr < 4; ++rr)
#pragma unroll
                for (int q = 0; q < 4; ++q) { const int t = 4 * hh + q + 8 * rr; XC[t * 68 + 32 * nt + tl] = bflo(w[rr][q]) + bfhi(w[rr][q]) * hin[nt]; }
            hin[nt] = BA[((blk * 2 + nt) * 2 + 0) * 64 + lane] * hin[nt] + BA[((blk * 2 + nt) * 2 + 1) * 64 + lane];
        }
        asm volatile("" ::: "memory");
        const int r8 = lane >> 3, c8 = lane & 7;
#pragma unroll
        for (int p = 0; p < 4; ++p) {
            const int row = 8 * p + r8;
            const f32x4 v0 = *(const LAS f32x4*)(XC + row * 68 + c8 * 8), v1 = *(const LAS f32x4*)(XC + row * 68 + c8 * 8 + 4);
            float ss = (v0[0] * v0[0] + v0[1] * v0[1]) + (v0[2] * v0[2] + v0[3] * v0[3]) + (v1[0] * v1[0] + v1[1] * v1[1]) + (v1[2] * v1[2] + v1[3] * v1[3]);
            ss += __shfl_xor(ss, 1); ss += __shfl_xor(ss, 2); ss += __shfl_xor(ss, 4);
            const float rs = rsqrtf(ss * (1.f / HD) + EPS);
            const f32x4 o0 = v0 * rs * gnv0, o1 = v1 * rs * gnv1;
            u32x4 wv; wv.x = cvt_pk_bf16(o0[0], o0[1]); wv.y = cvt_pk_bf16(o0[2], o0[3]); wv.z = cvt_pk_bf16(o1[0], o1[1]); wv.w = cvt_pk_bf16(o1[2], o1[3]);
            *(u32x4*)(yb + (size_t)(m0 + row) * D + h * HD + c8 * 8) = wv;
        }
        asm volatile("" ::: "memory");
    }
}

__device__ __forceinline__ void sc_half(ArgsP a, int lane, int l, int b, int chunk, int g, int half) {
    const bf16_t* u = (const bf16_t*)(a->ws + WS_U);
    bf16_t* yb = (bf16_t*)(a->ws + WS_YB);
    const int r4 = lane >> 3, c8 = lane & 7, c0 = g * HD + c8 * 8;
    float w0[8], w1[8], w2[8], gn[8];
#pragma unroll
    for (int q = 0; q < 8; ++q) { w0[q] = a->in[13][(l * 3 + 0) * DS + c0 + q]; w1[q] = a->in[13][(l * 3 + 1) * DS + c0 + q]; w2[q] = a->in[13][(l * 3 + 2) * DS + c0 + q]; gn[q] = a->in[15][l * DS + c0 + q]; }
    for (int step = half * 2; step < half * 2 + 2; ++step) {
        const int tb = chunk * 128 + step * 32 + r4 * 4, m = b * SEQ + tb;
        float p[6][8];
#pragma unroll
        for (int i = 0; i < 6; ++i) {
            u32x4 cv = {0u, 0u, 0u, 0u}, xv = {0u, 0u, 0u, 0u};
            if (tb - 2 + i >= 0) { cv = *(const u32x4*)(u + (size_t)(m - 2 + i) * DIN + 1536 + c0); xv = *(const u32x4*)(u + (size_t)(m - 2 + i) * DIN + 2048 + c0); }
#pragma unroll
            for (int q = 0; q < 4; ++q) { p[i][2 * q] = bflo(cv[q]) * bflo(xv[q]); p[i][2 * q + 1] = bfhi(cv[q]) * bfhi(xv[q]); }
        }
#pragma unroll
        for (int r = 0; r < 4; ++r) {
            const u32x4 bv = *(const u32x4*)(u + (size_t)(m + r) * DIN + 1024 + c0);
            float y[8]; float ss = 0.f;
#pragma unroll
            for (int q = 0; q < 8; ++q) { const float bq = (q & 1) ? bfhi(bv[q >> 1]) : bflo(bv[q >> 1]); y[q] = bq * (w0[q] * p[r][q] + w1[q] * p[r + 1][q] + w2[q] * p[r + 2][q]); ss += y[q] * y[q]; }
            ss += __shfl_xor(ss, 1); ss += __shfl_xor(ss, 2); ss += __shfl_xor(ss, 4);
            const float rs = rsqrtf(ss * (1.f / HD) + EPS);
            u32x4 w; w.x = cvt_pk_bf16(y[0] * rs * gn[0], y[1] * rs * gn[1]); w.y = cvt_pk_bf16(y[2] * rs * gn[2], y[3] * rs * gn[3]); w.z = cvt_pk_bf16(y[4] * rs * gn[4], y[5] * rs * gn[5]); w.w = cvt_pk_bf16(y[6] * rs * gn[6], y[7] * rs * gn[7]);
            *(u32x4*)(yb + (size_t)(m + r) * D + DL + c0) = w;
        }
    }
}

template <bool FULL>
__device__ __forceinline__ void phase_mix(const Frame& F0, int l) {
    ArgsP a = args_ptr();
    const FrameL F = frame_local(F0);
    const int h = F.vcu & 7, q = F.vcu >> 3;
    {
        const int pair = F.wave & 3, half = F.wave >> 2, pr = q * 4 + pair, b = pr >> 5, chunk = pr & 31;
        lru_half(a, F.lane, l, b, chunk, h, pair, half, F.lds);
    }
}

constexpr int PH_PER_LAYER = 7, PH_FINAL = 1 + PH_PER_LAYER * DEPTH, N_PHASES = PH_FINAL + 1;
__global__ void __launch_bounds__(NTHREADS, 2) mk_fwd(Args args) {
    extern __shared__ __attribute__((aligned(16))) unsigned char lds_raw[];
    Frame F;
    F.lds = (LAS unsigned char*)lds_raw;
    F.MISC = (volatile LAS unsigned*)(F.lds + MISC_OFF);
    F.wave = __builtin_amdgcn_readfirstlane((int)threadIdx.x >> 6);
    F.G = gridDim.x; { const int bx = blockIdx.x; F.vcu = (F.G % 8 == 0) ? (bx % 8) * (F.G / 8) + bx / 8 : bx; }
    F.ctl = (unsigned*)(args.ws + WS_CTL);
    if (threadIdx.x < 64) ((LAS unsigned*)(F.lds + MISC_OFF))[threadIdx.x] = 0u;
    __syncthreads();
    const int lo = args.ph_lo, hi = args.ph_hi;
    const bool multi = (hi - lo) > 1;
    XcdBarrier bar; bar.bar = F.ctl + CW_BAR; bar.x = 0; bar.st = nullptr;
    if (multi) bar = xcd_barrier_post(F.ctl + CW_BAR, F.MISC + 8);
#define IN(k) (lo <= (k) && (k) < hi)
#define SEAM(k) do { if (IN(k) && IN((k) + 1)) { for (int rb_ = 0; rb_ < REP_BAR; ++rb_) xcd_barrier(bar, F.wave); } else __syncthreads(); } while (0)
    unsigned char* ws = args.ws;
    float* xres = args.out;
    float* modall = (float*)(ws + WS_MOD);
    bf16_t* HB = (bf16_t*)(ws + WS_HB); bf16_t* YB = (bf16_t*)(ws + WS_YB); bf16_t* UB = (bf16_t*)(ws + WS_U); float* YS = (float*)(ws + WS_YS);

    if (IN(0)) { for (int rp_ = 0; rp_ < REP_PRO; ++rp_) { phase_prologue(F); __syncthreads(); } } SEAM(0);

    for (int l = 0; l < DEPTH; ++l) {
        const int pb = 1 + PH_PER_LAYER * l;
        const int j = l >> 1; const bool moe = (l & 1) != 0;
        const float* mod_mix = modall + (size_t)(2 * l) * 4 * 3072; const float* mod_ffn = modall + (size_t)(2 * l + 1) * 4 * 3072;
        unsigned* cnt_cur = F.ctl + CW_CNT + j * 8 * 64;
        if (IN(pb + 0)) {
            const bool comb = (l > 0) && (((l - 1) & 1) != 0);
            const int lp = l > 0 ? l - 1 : 0;
            const float* gate_prev = modall + (size_t)(2 * lp + 1) * 4 * 3072 + 2048;
            const unsigned* cnt_prev = F.ctl + CW_CNT + (lp >> 1) * 8 * 64;
            for (int rp_ = 0; rp_ < (l == 0 ? REP_NORM0 : 1); ++rp_) {
            ArgsP ap = args_ptr();
            phase_norm(ap, F, l == 0 ? ap->in[0] : xres, xres, ap->in[2] + l * D, mod_mix, comb, gate_prev, cnt_prev, false, false, nullptr, nullptr, nullptr);
            __syncthreads(); }
        } SEAM(pb + 0);
        if (IN(pb + 1)) {
            pg8::Gemm g{HB, (const bf16_t*)(ws + WS_WIN) + (size_t)l * DIN * D, D};
            pg8::DenseOrder S; S.init(M / 256, DIN / 256, F.G, (int)blockIdx.x); S.rowbytes = D * 2;
            pg8::EpiBf16 E{UB, DIN};
            pg8::gemm_phase(F.lds, F.wave, g, S, E);
        } SEAM(pb + 1);
        if (IN(pb + 2)) { phase_mix<true>(F, l); } SEAM(pb + 2);
        if (IN(pb + 3)) {
            pg8::Gemm g{YB, (const bf16_t*)(ws + WS_WOUT) + (size_t)l * D * D, D};
            pg8::DenseOrder S; S.init(M / 256, D / 256, F.G, (int)blockIdx.x); S.rowbytes = D * 2;
            ArgsP ap = args_ptr();
            pg8::EpiRes E{l == 0 ? ap->in[0] : xres, xres, mod_mix + 2048};
            pg8::gemm_phase(F.lds, F.wave, g, S, E);
        } SEAM(pb + 3);
        if (IN(pb + 4)) {
            ArgsP ap = args_ptr();
            phase_norm(ap, F, xres, xres, ap->in[17] + l * D, mod_ffn, false, nullptr, nullptr, false, moe, ap->in[23] + (size_t)j * D * NE, ap->in[24] + j * NE, cnt_cur);
        } SEAM(pb + 4);
        if (IN(pb + 5)) {
            if (!moe) {
                pg8::Gemm g{HB, (const bf16_t*)(ws + WS_W13D) + (size_t)j * 2 * DFF * D, D};
                pg8::DenseOrder S; S.init(M / 256, 2 * DFF / 256, F.G, (int)blockIdx.x); S.rowbytes = D * 2;
                pg8::EpiSwiGLU E{UB, DFF};
                pg8::gemm_phase(F.lds, F.wave, g, S, E);
            } else {
                pg8::Gemm g{HB, (const bf16_t*)(ws + WS_W13E) + (size_t)j * NE * 2 * DFE * D, D};
                pg8::MoeOrder S; moe_offsets(cnt_cur, S.cnt, S.toff); S.init(S.toff[8], 2 * DFE / 256, F.G, (int)blockIdx.x); S.rowbytes = D * 2; S.list = (const int*)(ws + WS_LIST); S.gather = true;
                pg8::EpiSwiGLU E{UB, DFE};
                pg8::gemm_phase(F.lds, F.wave, g, S, E);
            }
        } SEAM(pb + 5);
        if (IN(pb + 6)) {
            if (!moe) {
                pg8::Gemm g{UB, (const bf16_t*)(ws + WS_W2D) + (size_t)j * D * DFF, DFF};
                pg8::DenseOrder S; S.init(M / 256, D / 256, F.G, (int)blockIdx.x); S.rowbytes = DFF * 2;
                pg8::EpiRes E{xres, xres, mod_ffn + 2048};
                pg8::gemm_phase(F.lds, F.wave, g, S, E);
            } else {
                pg8::Gemm g{UB, (const bf16_t*)(ws + WS_W2E) + (size_t)j * NE * D * DFE, DFE};
                pg8::MoeOrder S; moe_offsets(cnt_cur, S.cnt, S.toff); S.init(S.toff[8], D / 256, F.G, (int)blockIdx.x); S.rowbytes = DFE * 2; S.list = nullptr; S.gather = false;
                pg8::EpiBf16 E{(bf16_t*)YS, D};
                pg8::gemm_phase(F.lds, F.wave, g, S, E);
            }
        } SEAM(pb + 6);
    }
    if (IN(PH_FINAL)) {
        const float* gate_prev = modall + (size_t)(2 * (DEPTH - 1) + 1) * 4 * 3072 + 2048;
        const unsigned* cnt_prev = F.ctl + CW_CNT + ((DEPTH - 1) >> 1) * 8 * 64;
        ArgsP ap = args_ptr();
        phase_norm(ap, F, xres, xres, ap->in[28], nullptr, true, gate_prev, cnt_prev, true, false, nullptr, nullptr, nullptr);
    }
#undef IN
#undef SEAM
}
}

extern "C" void kernel_launch(void* const* d_in, const int* in_sizes, int n_in, void* d_out, int out_size, void* d_ws, size_t ws_size, hipStream_t stream) {
    static int grid = 0;
    if (grid == 0) {
        if (n_in != 29 || out_size != M * D || ws_size < WS_END) { fprintf(stderr, "kernel_launch: unexpected sizes (n_in %d out %d ws %zu)\n", n_in, out_size, ws_size); grid = -1; return; }
        int dev = 0, cus = 0, per_cu = 0;
        if (hipGetDevice(&dev) != hipSuccess || hipDeviceGetAttribute(&cus, hipDeviceAttributeMultiprocessorCount, dev) != hipSuccess) { grid = -1; return; }
        if (hipFuncSetAttribute((const void*)mk_fwd, hipFuncAttributeMaxDynamicSharedMemorySize, LDS_BYTES) != hipSuccess) { fprintf(stderr, "kernel_launch: hipFuncSetAttribute failed\n"); grid = -1; return; }
        if (hipOccupancyMaxActiveBlocksPerMultiprocessor(&per_cu, (const void*)mk_fwd, NTHREADS, LDS_BYTES) != hipSuccess || per_cu < 1) { fprintf(stderr, "kernel_launch: occupancy query says %d\n", per_cu); (void)hipGetLastError(); }
        grid = cus;
    }
    if (grid < 0) return;
    (void)hipMemsetAsync((char*)d_ws + WS_CTL, 0, CTL_ZERO_BYTES, stream);
    Args a{};
    for (int i = 0; i < 29; ++i) a.in[i] = (const float*)d_in[i];
    a.out = (float*)d_out; a.ws = (unsigned char*)d_ws;
#if MK_SINGLE
    a.ph_lo = 0; a.ph_hi = N_PHASES;
    hipLaunchKernelGGL(mk_fwd, dim3(grid), dim3(NTHREADS), LDS_BYTES, stream, a);
#else
    for (int p = 0; p < N_PHASES; ++p) { a.ph_lo = p; a.ph_hi = p + 1; hipLaunchKernelGGL(mk_fwd, dim3(grid), dim3(NTHREADS), LDS_BYTES, stream, a); }
#endif
}
```
